# Optimizing an MI355X kernel written in HIP

```python
import jax, jax.numpy as jnp
from jax import lax
import numpy as np

D_MODEL = 1024
BATCH = 8
SEQ = 2048
DEPTH = 1

LN_EPS = 1e-5
RMS_EPS = 1e-6

GLA_HEADS = 4
GLA_DK = D_MODEL // 2
GLA_DV = D_MODEL
GLA_HK = GLA_DK // GLA_HEADS
GLA_HV = GLA_DV // GLA_HEADS
GLA_GATE_RANK = 16
GLA_TAU = 16.0
GLA_CHUNK = 64

MLA_HEADS = 8
MLA_Q_RANK = 384
MLA_KV_RANK = 256
MLA_NOPE = 128
MLA_ROPE = 64
MLA_V = 128
MLA_QK = MLA_NOPE + MLA_ROPE
ROPE_THETA = 10000.0
Q_BLOCK = 128

D_FF = 4 * D_MODEL

N_BRANCH = 2
DEEPNORM_ALPHA = (2.0 * DEPTH) ** 0.25
DEEPNORM_BETA = (8.0 * DEPTH) ** -0.25

IN_SPLITS = (GLA_DK, GLA_DK, GLA_DV, GLA_DV, GLA_GATE_RANK, MLA_Q_RANK, MLA_KV_RANK + MLA_ROPE, N_BRANCH * D_MODEL)
D_IN = sum(IN_SPLITS)

kernel_name = 'hybrid_gla_mla_deepnorm_block'


def layer_norm(x, g, b):
    xf = x.astype(jnp.float32)
    mu = jnp.mean(xf, axis=-1, keepdims=True)
    var = jnp.mean(jnp.square(xf - mu), axis=-1, keepdims=True)
    return ((xf - mu) * lax.rsqrt(var + LN_EPS) * g + b).astype(x.dtype)


def rms_norm(x, g):
    xf = x.astype(jnp.float32)
    return (xf * lax.rsqrt(jnp.mean(jnp.square(xf), axis=-1, keepdims=True) + RMS_EPS) * g).astype(x.dtype)


def rope_tables(positions):
    inv_freq = 1.0 / (ROPE_THETA ** (jnp.arange(0, MLA_ROPE, 2, dtype=jnp.float32) / MLA_ROPE))
    ang = positions.astype(jnp.float32)[..., None] * inv_freq
    return jnp.cos(ang), jnp.sin(ang)


def apply_rope(x, cos, sin):
    half = x.shape[-1] // 2
    xf = x.astype(jnp.float32)
    x1, x2 = xf[..., :half], xf[..., half:]
    return jnp.concatenate([x1 * cos - x2 * sin, x2 * cos + x1 * sin], axis=-1).astype(x.dtype)


def split_heads(t, n_heads):
    b, s, _ = t.shape
    return t.reshape(b, s, n_heads, -1).transpose(0, 2, 1, 3)


def merge_heads(t):
    b, h, s, d = t.shape
    return t.transpose(0, 2, 1, 3).reshape(b, s, h * d)


def gla_chunked(q, k, v, log_a):
    bsz, nh, seq, dk = q.shape
    dv = v.shape[-1]
    n_chunks = seq // GLA_CHUNK

    def to_chunks(t):
        return t.reshape(bsz, nh, n_chunks, GLA_CHUNK, t.shape[-1]).transpose(2, 0, 1, 3, 4)

    causal = jnp.tril(jnp.ones((GLA_CHUNK, GLA_CHUNK), dtype=bool))

    def step(state, inp):
        qi, ki, vi, gi = inp
        b = jnp.cumsum(gi, axis=2)
        b_last = b[:, :, -1:, :]
        diff = b[:, :, :, None, :] - b[:, :, None, :, :]
        decay = jnp.exp(jnp.where(causal[:, :, None], diff, -jnp.inf))
        scores = jnp.einsum('bhid,bhjd,bhijd->bhij', qi, ki, decay)
        o = jnp.einsum('bhij,bhjv->bhiv', scores, vi) + jnp.einsum('bhid,bhdv->bhiv', qi * jnp.exp(b), state)
        state = jnp.exp(b_last)[:, :, 0, :, None] * state + jnp.einsum('bhjd,bhjv->bhdv', ki * jnp.exp(b_last - b), vi)
        return state, o

    state0 = jnp.zeros((bsz, nh, dk, dv), jnp.float32)
    _, o = lax.scan(step, state0, (to_chunks(q), to_chunks(k), to_chunks(v), to_chunks(log_a)))
    return o.transpose(1, 2, 0, 3, 4).reshape(bsz, nh, seq, dv)


def mla_causal_attention(q_nope, q_rope, k_nope, k_rope, v):
    seq = q_nope.shape[2]
    scale = MLA_QK ** -0.5
    outs = []
    for blk in range(seq // Q_BLOCK):
        q0, q1 = blk * Q_BLOCK, (blk + 1) * Q_BLOCK
        s = (jnp.einsum('bhqd,bhkd->bhqk', q_nope[:, :, q0:q1], k_nope[:, :, :q1])
             + jnp.einsum('bhqr,bkr->bhqk', q_rope[:, :, q0:q1], k_rope[:, :q1]))
        s = s.astype(jnp.float32) * scale
        mask = (q0 + jnp.arange(Q_BLOCK))[:, None] >= jnp.arange(q1)[None, :]
        p = jax.nn.softmax(jnp.where(mask, s, -jnp.inf), axis=-1).astype(v.dtype)
        outs.append(jnp.einsum('bhqk,bhkv->bhqv', p, v[:, :, :q1]))
    return jnp.concatenate(outs, axis=2)


def token_mixer(h, cos, sin, w_in, w_gla_a2, b_gla_a2, gla_norm_g, w_o_gla,
                q_a_norm_g, w_q_b, kv_a_norm_g, w_kv_b, w_o_mla, b_gate, w_out):
    bsz, seq, _ = h.shape
    offsets = np.cumsum(IN_SPLITS)[:-1].tolist()
    q_g, k_g, v_g, r_g, a_lr, q_lat, kv_lat, gate_logits = jnp.split(h @ w_in, offsets, axis=-1)

    log_a = jax.nn.log_sigmoid((a_lr @ w_gla_a2 + b_gla_a2).astype(jnp.float32)) / GLA_TAU
    o_gla = gla_chunked(split_heads(q_g.astype(jnp.float32), GLA_HEADS) * GLA_HK ** -0.5,
                        split_heads(k_g.astype(jnp.float32), GLA_HEADS),
                        split_heads(v_g.astype(jnp.float32), GLA_HEADS),
                        split_heads(log_a, GLA_HEADS))
    o_gla = rms_norm(o_gla.transpose(0, 2, 1, 3), gla_norm_g.reshape(GLA_HEADS, GLA_HV))
    o_gla = o_gla.reshape(bsz, seq, GLA_DV).astype(h.dtype)
    y_gla = (o_gla * jax.nn.silu(r_g)) @ w_o_gla

    q = (rms_norm(q_lat, q_a_norm_g) @ w_q_b).reshape(bsz, seq, MLA_HEADS, MLA_QK)
    q_nope = q[..., :MLA_NOPE]
    q_rope = apply_rope(q[..., MLA_NOPE:], cos[:, :, None], sin[:, :, None])
    c_kv = rms_norm(kv_lat[..., :MLA_KV_RANK], kv_a_norm_g)
    k_rope = apply_rope(kv_lat[..., MLA_KV_RANK:], cos, sin)
    kv = (c_kv @ w_kv_b).reshape(bsz, seq, MLA_HEADS, MLA_NOPE + MLA_V)
    k_nope, v = kv[..., :MLA_NOPE], kv[..., MLA_NOPE:]
    o_mla = mla_causal_attention(q_nope.transpose(0, 2, 1, 3), q_rope.transpose(0, 2, 1, 3),
                                 k_nope.transpose(0, 2, 1, 3), k_rope, v.transpose(0, 2, 1, 3))
    y_mla = merge_heads(o_mla) @ w_o_mla

    g_gla, g_mla = jnp.split(jax.nn.sigmoid(gate_logits + b_gate), N_BRANCH, axis=-1)
    return (g_gla * y_gla + g_mla * y_mla) @ w_out


def setup_inputs(seed: int = 0) -> dict:
    key = jax.random.key(seed)
    ks = jax.random.split(key, 24)
    f32 = jnp.float32

    def normal(k, shape, scale):
        return jax.random.normal(k, shape, f32) * scale

    def gain(k, shape):
        return 1.0 + 0.02 * jax.random.normal(k, shape, f32)

    beta = DEEPNORM_BETA
    x = jax.random.normal(ks[0], (BATCH, SEQ, D_MODEL), f32)
    offset = jax.random.randint(ks[1], (BATCH, 1), 0, 4096, dtype=jnp.int32)
    positions = offset + jnp.arange(SEQ, dtype=jnp.int32)[None, :]
    v_lo = 2 * GLA_DK
    in_col_scale = jnp.ones((D_IN,), f32).at[v_lo:v_lo + GLA_DV].set(beta)
    kv_col_scale = jnp.tile(jnp.concatenate([jnp.ones((MLA_NOPE,), f32), jnp.full((MLA_V,), beta, f32)]), MLA_HEADS)
    return {
        'x': x,
        'positions': positions,
        'ln_in_g': gain(ks[2], (D_MODEL,)),
        'ln_in_b': normal(ks[3], (D_MODEL,), 0.02),
        'w_in': normal(ks[4], (DEPTH, D_MODEL, D_IN), D_MODEL ** -0.5) * in_col_scale,
        'w_gla_a2': normal(ks[5], (DEPTH, GLA_GATE_RANK, GLA_DK), GLA_GATE_RANK ** -0.5),
        'b_gla_a2': normal(ks[6], (DEPTH, GLA_DK), 0.1),
        'gla_norm_g': gain(ks[7], (DEPTH, GLA_DV)),
        'w_o_gla': normal(ks[8], (DEPTH, GLA_DV, D_MODEL), beta * GLA_DV ** -0.5),
        'q_a_norm_g': gain(ks[9], (DEPTH, MLA_Q_RANK)),
        'w_q_b': normal(ks[10], (DEPTH, MLA_Q_RANK, MLA_HEADS * MLA_QK), MLA_Q_RANK ** -0.5),
        'kv_a_norm_g': gain(ks[11], (DEPTH, MLA_KV_RANK)),
        'w_kv_b': normal(ks[12], (DEPTH, MLA_KV_RANK, MLA_HEADS * (MLA_NOPE + MLA_V)), MLA_KV_RANK ** -0.5) * kv_col_scale,
        'w_o_mla': normal(ks[13], (DEPTH, MLA_HEADS * MLA_V, D_MODEL), beta * (MLA_HEADS * MLA_V) ** -0.5),
        'b_gate': normal(ks[14], (DEPTH, N_BRANCH * D_MODEL), 0.1),
        'w_out': normal(ks[15], (DEPTH, D_MODEL, D_MODEL), beta * D_MODEL ** -0.5),
        'ln1_g': gain(ks[16], (DEPTH, D_MODEL)),
        'ln1_b': normal(ks[17], (DEPTH, D_MODEL), 0.02),
        'w_ff1': normal(ks[18], (DEPTH, D_MODEL, D_FF), beta * D_MODEL ** -0.5),
        'w_ff2': normal(ks[19], (DEPTH, D_FF, D_MODEL), beta * D_FF ** -0.5),
        'ln2_g': gain(ks[20], (DEPTH, D_MODEL)),
        'ln2_b': normal(ks[21], (DEPTH, D_MODEL), 0.02),
    }


def reference(x, positions, ln_in_g, ln_in_b, w_in, w_gla_a2, b_gla_a2, gla_norm_g, w_o_gla,
              q_a_norm_g, w_q_b, kv_a_norm_g, w_kv_b, w_o_mla, b_gate, w_out,
              ln1_g, ln1_b, w_ff1, w_ff2, ln2_g, ln2_b):
    cos, sin = rope_tables(positions)
    h = layer_norm(x, ln_in_g, ln_in_b)
    for l in range(DEPTH):
        mix = token_mixer(h, cos, sin, w_in[l], w_gla_a2[l], b_gla_a2[l], gla_norm_g[l], w_o_gla[l],
                          q_a_norm_g[l], w_q_b[l], kv_a_norm_g[l], w_kv_b[l], w_o_mla[l], b_gate[l], w_out[l])
        h = layer_norm(DEEPNORM_ALPHA * h + mix, ln1_g[l], ln1_b[l])
        ff = jnp.square(jax.nn.relu(h @ w_ff1[l])) @ w_ff2[l]
        h = layer_norm(DEEPNORM_ALPHA * h + ff, ln2_g[l], ln2_b[l])
    return h
```

```cpp
#include <hip/hip_runtime.h>
#include <hip/hip_cooperative_groups.h>
#include <cstdio>
#include <cstdint>
namespace cg = cooperative_groups;

#ifndef MULTI_LAUNCH
#define MULTI_LAUNCH 0
#endif
#ifndef PROBE_ATTN2
#define PROBE_ATTN2 0
#endif
#ifndef PROBE_GLA2
#define PROBE_GLA2 0
#endif
#ifndef PROBE_PRE2
#define PROBE_PRE2 0
#endif
#ifndef PROBE_DUP
#define PROBE_DUP 0
#endif

#define DI __device__ __forceinline__
typedef unsigned short bf16_t;
typedef short bf16x8 __attribute__((ext_vector_type(8)));
typedef short s16x4 __attribute__((ext_vector_type(4)));
typedef float f32x4 __attribute__((ext_vector_type(4)));
typedef float f32x2 __attribute__((ext_vector_type(2)));
typedef float f32x16 __attribute__((ext_vector_type(16)));
typedef unsigned u32x4 __attribute__((ext_vector_type(4)));
typedef unsigned u32x2 __attribute__((ext_vector_type(2)));
typedef __bf16 bfv2 __attribute__((ext_vector_type(2)));

constexpr int M_TOK = 16384, DM = 1024, SEQ = 2048, NB = 8;
constexpr int NP = 3840;
constexpr int PQG = 0, PKG = 512, PVG = 1024, PRG = 2048, PQL = 3072, PCKV = 3456, PKR = 3712, PALR = 3776;
constexpr int DIN = 5840;
constexpr int QW = 1536;
constexpr float ALPHA = 1.189207115002721f;
constexpr float QSCALE = 0.07216878364870322f * 1.4426950408889634f;
constexpr float GLA_QS = 0.08838834764831845f;

constexpr size_t OFF_WT_IN = 0;
constexpr size_t OFF_WT_G = OFF_WT_IN + (size_t)NP * 1024 * 2;
constexpr size_t OFF_WT_Q = OFF_WT_G + (size_t)2048 * 1024 * 2;
constexpr size_t OFF_WT_KV = OFF_WT_Q + (size_t)1536 * 384 * 2;
constexpr size_t OFF_WT_OG = OFF_WT_KV + (size_t)2048 * 256 * 2;
constexpr size_t OFF_WT_OM = OFF_WT_OG + (size_t)1024 * 1024 * 2;
constexpr size_t OFF_WT_OUT = OFF_WT_OM + (size_t)1024 * 1024 * 2;
constexpr size_t OFF_COS = OFF_WT_OUT + (size_t)1024 * 1024 * 2;
constexpr size_t OFF_SIN = OFF_COS + (size_t)M_TOK * 32 * 4;
constexpr size_t OFF_SUM1 = OFF_COS, OFF_SUM2 = OFF_SUM1 + (size_t)M_TOK * 8, OFF_CNT1 = OFF_SUM2 + (size_t)M_TOK * 8, OFF_CNT2 = OFF_CNT1 + 64 * 256, OFF_XEND = OFF_CNT2 + 64 * 256;
static_assert(OFF_XEND <= OFF_COS + (size_t)M_TOK * 32 * 4, "exchange overlay");
constexpr size_t OFF_ST0 = OFF_SIN + (size_t)M_TOK * 32 * 4;
constexpr size_t OFF_ST1 = OFF_ST0 + (size_t)M_TOK * 2 * 4;
constexpr size_t OFF_P = OFF_ST1 + (size_t)M_TOK * 2 * 4;
constexpr size_t OFF_H0 = OFF_P + (size_t)M_TOK * NP * 2;
constexpr size_t OFF_KN = OFF_H0 + (size_t)M_TOK * 1024 * 2;
constexpr size_t OFF_VT = OFF_KN + (size_t)M_TOK * 1024 * 2;
constexpr size_t OFF_WT_FF2 = OFF_VT + (size_t)M_TOK * 1024 * 2;
constexpr size_t WS_END = OFF_WT_FF2 + (size_t)1024 * 4096 * 2;
constexpr size_t OFF_AS = WS_END;
constexpr size_t OFF_BAR = OFF_AS + (size_t)1024 * 4096 * 2;
constexpr int XCD_BAR_WORDS = 3456;
static_assert(OFF_BAR + XCD_BAR_WORDS * 4 <= (size_t)256 * 1024 * 1024, "workspace");
constexpr size_t OOFF_Q = 0;
constexpr size_t OOFF_WT_FF1 = (size_t)M_TOK * QW * 2;
constexpr size_t OOFF_SSQ = OOFF_WT_FF1 + (size_t)4096 * 1024 * 2;
constexpr size_t OOFF_EBL = OOFF_SSQ + (size_t)M_TOK * 4 * 16 * 4;
constexpr size_t OOFF_DUMMY = OOFF_EBL + (size_t)1024 * 128 * 4;
constexpr size_t OOFF_RSS = OOFF_DUMMY + (size_t)1024 * 1024;
static_assert(OOFF_RSS + (size_t)M_TOK * 2 * 4 <= (size_t)M_TOK * 1024 * 4, "out scratch");

constexpr int LDS_BYTES = 131072 + 4096;

struct Params {
  const float* x; const int* pos; const float* ln_in_g; const float* ln_in_b; const float* w_in; const float* w_gla_a2; const float* b_gla_a2;
  const float* gla_norm_g; const float* w_o_gla; const float* q_a_norm_g; const float* w_q_b; const float* kv_a_norm_g; const float* w_kv_b;
  const float* w_o_mla; const float* b_gate; const float* w_out; const float* ln1_g; const float* ln1_b; const float* w_ff1; const float* w_ff2;
  const float* ln2_g; const float* ln2_b;
  float* out; unsigned char* ws;
  int ph_lo, ph_hi;
};

extern __shared__ __attribute__((aligned(16))) unsigned char smem[];

DI unsigned pk2(float a, float b) { f32x2 v = {a, b}; bfv2 r = __builtin_convertvector(v, bfv2); return __builtin_bit_cast(unsigned, r); }
DI bf16_t f2bf(float a) { return (bf16_t)(pk2(a, 0.f) & 0xffffu); }
DI float bf2f(unsigned u) { return __uint_as_float(u << 16); }
DI float bflo(unsigned u) { return __uint_as_float(u << 16); }
DI float bfhi(unsigned u) { return __uint_as_float(u & 0xffff0000u); }
DI u32x2 pk4(f32x4 v) { u32x2 r; r.x = pk2(v[0], v[1]); r.y = pk2(v[2], v[3]); return r; }
DI f32x4 unpk4(u32x2 u) { f32x4 r = {bflo(u.x), bfhi(u.x), bflo(u.y), bfhi(u.y)}; return r; }
DI float sigmoidf_(float x) { return __builtin_amdgcn_rcpf(1.0f + __expf(-x)); }
DI float xor32_max(float v) { const auto r = __builtin_amdgcn_permlane32_swap(__float_as_uint(v), __float_as_uint(v), false, false); return fmaxf(__uint_as_float(r[0]), __uint_as_float(r[1])); }
DI float xor32_sum(float v) { const auto r = __builtin_amdgcn_permlane32_swap(__float_as_uint(v), __float_as_uint(v), false, false); return __uint_as_float(r[0]) + __uint_as_float(r[1]); }
DI float xor16_sum(float v) { const auto r = __builtin_amdgcn_permlane16_swap(__float_as_uint(v), __float_as_uint(v), false, false); return __uint_as_float(r[0]) + __uint_as_float(r[1]); }
DI float row16_sum(float v) {
  v += __builtin_bit_cast(float, __builtin_amdgcn_update_dpp(0, __builtin_bit_cast(int, v), 0xB1, 0xF, 0xF, true));
  v += __builtin_bit_cast(float, __builtin_amdgcn_update_dpp(0, __builtin_bit_cast(int, v), 0x4E, 0xF, 0xF, true));
  v += __builtin_bit_cast(float, __builtin_amdgcn_update_dpp(0, __builtin_bit_cast(int, v), 0x141, 0xF, 0xF, true));
  v += __builtin_bit_cast(float, __builtin_amdgcn_update_dpp(0, __builtin_bit_cast(int, v), 0x140, 0xF, 0xF, true));
  return v;
}
DI float wave_sum(float v) { return xor32_sum(xor16_sum(row16_sum(v))); }
DI unsigned xb_ld(unsigned* p) { return __hip_atomic_load(p, __ATOMIC_RELAXED, __HIP_MEMORY_SCOPE_AGENT); }
DI unsigned xb_add(unsigned* p, unsigned v) { return __hip_atomic_fetch_add(p, v, __ATOMIC_RELAXED, __HIP_MEMORY_SCOPE_AGENT); }

#define LBAR() do { asm volatile("s_waitcnt lgkmcnt(0)" ::: "memory"); __builtin_amdgcn_s_barrier(); asm volatile("" ::: "memory"); } while (0)

constexpr int HTB = 128 * 64 * 2;
DI int lds_byte(int r, int c) { int st = (r >> 4) * 2 + (c >> 5), rr = r & 15, cc = c & 31, ob = rr * 64 + cc * 2; return st * 1024 + (ob ^ (((ob >> 9) & 1) << 5)); }
DI void stage_rc(int b, int& R, int& C) { int st = b / 1024, sb = b % 1024, swz = sb ^ (((sb >> 9) & 1) << 5); R = (st >> 1) * 16 + swz / 64; C = (st & 1) * 32 + (swz % 64) / 2; }

enum { EPI_PROJ = 0, EPI_Q = 1, EPI_KV = 2, EPI_BF16 = 3, EPI_MERGE = 4, EPI_RES = 5, EPI_FF1 = 6, EPI_YG = 7, EPI_RESLN1 = 8, EPI_RESLN2 = 9 };
struct Sub {
  const bf16_t* A; int lda; int akblk; const bf16_t* Bt; int K; int nN; int epi; int rsK;
  void* o0; void* o1; int ldo;
  const float* f0; const float* f1; const float* f2; const float* f3; const bf16_t* b0; const bf16_t* b1;
  float* sums; unsigned* cnt; const float* g2; const float* be2; float* st_out;
};

#define LAS __attribute__((address_space(3)))
#define G_SA(b, h) (((b) * 2 + (h)) * HTB)
#define G_SB(b, h) ((4 + (b) * 2 + (h)) * HTB)

DI void store_bf4(bf16_t* p, f32x4 v) { *(u32x2*)p = pk4(v); }
DI void store_bf8(bf16_t* p, f32x4 a, f32x4 b) { const u32x4 w = {pk2(a[0], a[1]), pk2(a[2], a[3]), pk2(b[0], b[1]), pk2(b[2], b[3])}; *(u32x4*)p = w; }
DI int perm32(int rho) { const int n = rho >> 4, i = rho & 15; return 8 * (i >> 2) + 4 * n + (i & 3); }

template <int EPI>
DI void gemm_epilogue(const Sub& s, f32x4 (&acc)[2][2][4][2], int brow, int bcol, const unsigned char* ws) {
  int tid = threadIdx.x; asm volatile("" : "+v"(tid));
  const int wid = tid >> 6, lane = tid & 63, wr = wid >> 2, wc = wid & 3, fr = lane & 15, fq = lane >> 4;
  const float* rstd = (const float*)(smem + 131072);
  constexpr int epi = EPI;
  if (epi == EPI_PROJ || epi == EPI_Q) {
    const float* COS = (const float*)(ws + OFF_COS); const float* SIN = (const float*)(ws + OFF_SIN);
    bf16_t* O = (bf16_t*)s.o0; const int ldo = s.ldo;
#pragma unroll
    for (int ai = 0; ai < 2; ++ai)
#pragma unroll
      for (int m = 0; m < 4; ++m) {
        const int rl = ai * 128 + wr * 64 + m * 16 + fr, row = brow + rl;
        const float sc = (epi == EPI_Q) ? rsqrtf(s.f1[2 * row] * (1.0f / 384.0f) + 1e-6f) * QSCALE : 1.0f;
#pragma unroll
        for (int bj = 0; bj < 2; ++bj) {
          const int c32 = bcol + bj * 128 + wc * 32;
          int ra;
          if (epi == EPI_PROJ) ra = (c32 == PKR) ? 0 : ((c32 == PKR + 32) ? 1 : -1);
          else { const int w32 = c32 % 192; ra = (w32 >= 128) ? ((w32 - 128) >> 5) : -1; }
          f32x4 v0 = acc[ai][bj][m][0] * sc, v1 = acc[ai][bj][m][1] * sc;
          if (ra >= 0) {
            const unsigned ci = (unsigned)row * 32u + ra * 16 + fq * 4; const f32x4 c4 = *(const f32x4*)(COS + ci), s4 = *(const f32x4*)(SIN + ci);
            const f32x4 o0 = v0 * c4 - v1 * s4, o1 = v1 * c4 + v0 * s4; v0 = o0; v1 = o1;
          }
          store_bf8(O + ((unsigned)row * (unsigned)ldo + c32 + fq * 8), v0, v1);
          if (epi == EPI_PROJ && c32 >= PQL && c32 < PKR) {
            float sq = (v0[0] * v0[0] + v0[1] * v0[1]) + (v0[2] * v0[2] + v0[3] * v0[3]) + (v1[0] * v1[0] + v1[1] * v1[1]) + (v1[2] * v1[2] + v1[3] * v1[3]);
            sq = xor32_sum(xor16_sum(sq));
            if (fq == 0) unsafeAtomicAdd(const_cast<float*>(s.f1) + 2 * row + (c32 >= PCKV ? 1 : 0), sq);
          }
        }
      }
  } else if (epi == EPI_KV) {
    bf16_t* KN = (bf16_t*)s.o0; bf16_t* VT = (bf16_t*)s.o1;
#pragma unroll
    for (int ai = 0; ai < 2; ++ai)
#pragma unroll
      for (int m = 0; m < 4; ++m) {
        const int rl = ai * 128 + wr * 64 + m * 16 + fr, row = brow + rl;
        const float sc = rsqrtf(s.f1[2 * row + 1] * (1.0f / 256.0f) + 1e-6f);
        const int b = row >> 11, sq = row & 2047;
#pragma unroll
        for (int bj = 0; bj < 2; ++bj) {
          const int c32 = bcol + bj * 128 + wc * 32, head = c32 >> 8, w32 = c32 & 255;
          { const f32x4 v0 = acc[ai][bj][m][0] * sc, v1 = acc[ai][bj][m][1] * sc;
            if (w32 < 128) store_bf8(KN + ((unsigned)row * 1024u + head * 128 + w32 + fq * 8), v0, v1);
            else store_bf8(VT + ((unsigned)row * 1024u + head * 128 + (w32 - 128) + fq * 8), v0, v1);
          }
        }
        asm volatile("" ::: "memory");
      }
  } else if (epi == EPI_BF16 || epi == EPI_FF1 || epi == EPI_YG) {
    bf16_t* O = (bf16_t*)s.o0; const int ldo = s.ldo;
#pragma unroll
    for (int ai = 0; ai < 2; ++ai)
#pragma unroll
      for (int m = 0; m < 4; ++m) {
        const int rl = ai * 128 + wr * 64 + m * 16 + fr, row = brow + rl;
        const float fin = (epi == EPI_YG) ? rstd[768 + rl] : 1.0f;
#pragma unroll
        for (int bj = 0; bj < 2; ++bj) {
          f32x4 v0 = acc[ai][bj][m][0] * fin, v1 = acc[ai][bj][m][1] * fin;
          if (epi == EPI_FF1) {
#pragma unroll
            for (int e = 0; e < 4; ++e) { const float r0 = fmaxf(v0[e], 0.f), r1 = fmaxf(v1[e], 0.f); v0[e] = r0 * r0; v1[e] = r1 * r1; }
          }
          store_bf8(O + ((unsigned)row * (unsigned)ldo + bcol + bj * 128 + wc * 32 + fq * 8), v0, v1);
        }
      }
  } else if (epi == EPI_MERGE) {
    bf16_t* O = (bf16_t*)s.o0; const float* bg = s.f0; const bf16_t* YG = s.b0; const bf16_t* YM = s.b1;
#pragma unroll
    for (int ai = 0; ai < 2; ++ai)
#pragma unroll
      for (int m = 0; m < 4; ++m) {
        const int row = brow + ai * 128 + wr * 64 + m * 16 + fr;
        { const int ch = (bcol >> 1) + wc * 32 + fq * 8;
          const unsigned oi = (unsigned)row * 1024u + ch;
          const u32x4 ygw = *(const u32x4*)(YG + oi), ymw = *(const u32x4*)(YM + oi);
          f32x4 o[2];
#pragma unroll
          for (int n = 0; n < 2; ++n) {
            const f32x4 a0 = acc[ai][0][m][n] + *(const f32x4*)(bg + ch + 4 * n), a1 = acc[ai][1][m][n] + *(const f32x4*)(bg + 1024 + ch + 4 * n);
            const f32x4 yg = unpk4((u32x2){ygw[2 * n], ygw[2 * n + 1]}), ym = unpk4((u32x2){ymw[2 * n], ymw[2 * n + 1]});
#pragma unroll
            for (int e = 0; e < 4; ++e) o[n][e] = sigmoidf_(a0[e]) * yg[e] + sigmoidf_(a1[e]) * ym[e];
          }
          store_bf8(O + oi, o[0], o[1]);
        }
      }
  } else if (epi == EPI_RESLN1 || epi == EPI_RESLN2) {
    const float* SRC = s.f0; const float* ST = s.f1; const float* GA = s.f2; const float* BE = s.f3;
    float* sums = s.sums; unsigned* cnt = s.cnt + 64 * (brow >> 8);
#pragma unroll
    for (int ai = 0; ai < 2; ++ai)
#pragma unroll
      for (int m = 0; m < 4; ++m) {
        const int row = brow + ai * 128 + wr * 64 + m * 16 + fr;
        int fqo = fq; asm volatile("" : "+v"(fqo));
        float mu = 0.f, rs = 0.f; if (epi == EPI_RESLN1) { mu = ST[2 * row]; rs = ST[2 * row + 1]; }
        float s1 = 0.f, s2 = 0.f;
#pragma unroll
        for (int bj = 0; bj < 2; ++bj)
#pragma unroll
          for (int n = 0; n < 2; ++n) {
            const int col = bcol + bj * 128 + wc * 32 + n * 16 + fqo * 4;
            const unsigned oi = (unsigned)row * 1024u + col;
            f32x4 hres;
            if (epi == EPI_RESLN1) { const f32x4 xs = *(const f32x4*)(SRC + oi), g4 = *(const f32x4*)(GA + col), b4 = *(const f32x4*)(BE + col); hres = (xs - mu) * rs * g4 + b4; }
            else hres = unpk4(*(const u32x2*)(s.b0 + oi));
            const f32x4 v = hres * ALPHA + acc[ai][bj][m][n];
            acc[ai][bj][m][n] = v;
            s1 += (v[0] + v[1]) + (v[2] + v[3]); s2 += (v[0] * v[0] + v[1] * v[1]) + (v[2] * v[2] + v[3] * v[3]);
            asm volatile("" ::: "memory");
          }
        s1 = xor32_sum(xor16_sum(s1)); s2 = xor32_sum(xor16_sum(s2));
        if (fq == 0) { unsafeAtomicAdd(sums + 2 * row, s1); unsafeAtomicAdd(sums + 2 * row + 1, s2); }
        asm volatile("" ::: "memory");
      }
    asm volatile("s_waitcnt vmcnt(0)" ::: "memory");
    if (lane == 0) (void)xb_add(cnt, 1u);
    { unsigned sp = 0u;
      while ((unsigned)__builtin_amdgcn_readfirstlane(xb_ld(cnt)) < 32u) { __builtin_amdgcn_s_sleep(1); if (++sp > (1u << 22)) break; } }
    asm volatile("" ::: "memory");
#pragma unroll
    for (int ai = 0; ai < 2; ++ai)
#pragma unroll
      for (int m = 0; m < 4; ++m) {
        const int row = brow + ai * 128 + wr * 64 + m * 16 + fr;
        int fqo = fq; asm volatile("" : "+v"(fqo));
        const float t1 = __hip_atomic_load(sums + 2 * row, __ATOMIC_RELAXED, __HIP_MEMORY_SCOPE_AGENT), t2 = __hip_atomic_load(sums + 2 * row + 1, __ATOMIC_RELAXED, __HIP_MEMORY_SCOPE_AGENT);
        const float mean = t1 * (1.0f / 1024.0f), var = fmaxf(t2 * (1.0f / 1024.0f) - mean * mean, 0.f), rstd2 = rsqrtf(var + 1e-5f);
#pragma unroll
        for (int bj = 0; bj < 2; ++bj)
#pragma unroll
          for (int n = 0; n < 2; ++n) {
            const int col = bcol + bj * 128 + wc * 32 + n * 16 + fqo * 4;
            const unsigned oi = (unsigned)row * 1024u + col;
            const f32x4 v = acc[ai][bj][m][n];
            const f32x4 y = (v - mean) * rstd2 * *(const f32x4*)(s.g2 + col) + *(const f32x4*)(s.be2 + col);
            if (epi == EPI_RESLN1) store_bf4((bf16_t*)s.o1 + oi, y);
            else *(f32x4*)((float*)s.o0 + oi) = y;
            asm volatile("" ::: "memory");
          }
        asm volatile("" ::: "memory");
      }
  } else {
    float* O = (float*)s.o0; const float* SRC = s.f0; const float* ST = s.f1; const float* GA = s.f2; const float* BE = s.f3;
#pragma unroll
    for (int ai = 0; ai < 2; ++ai)
#pragma unroll
      for (int m = 0; m < 4; ++m) {
        const int row = brow + ai * 128 + wr * 64 + m * 16 + fr;
        const float mu = ST[2 * row], rs = ST[2 * row + 1];
#pragma unroll
        for (int bj = 0; bj < 2; ++bj)
#pragma unroll
          for (int n = 0; n < 2; ++n) {
            const int col = bcol + bj * 128 + wc * 32 + n * 16 + fq * 4;
            const unsigned oi = (unsigned)row * 1024u + col; const f32x4 xs = *(const f32x4*)(SRC + oi), g4 = *(const f32x4*)(GA + col), b4 = *(const f32x4*)(BE + col);
            const f32x4 h = (xs - mu) * rs * g4 + b4;
            *(f32x4*)(O + oi) = h * ALPHA + acc[ai][bj][m][n];
          }
      }
  }
}

template <int EPI>
DI void gemm_phase(const Sub& s, const unsigned char* ws) {
  constexpr bool RS = (EPI == EPI_YG), TAB = (EPI == EPI_YG), ALIGN = true;
  LAS unsigned char* lds = (LAS unsigned char*)smem;
  int tid = threadIdx.x; asm volatile("" : "+v"(tid));
  const int wid = __builtin_amdgcn_readfirstlane(tid >> 6), lane = tid & 63, wr = wid >> 2, wc = wid & 3, fr = lane & 15, fq = lane >> 4;
  const int c = blockIdx.x, G = gridDim.x, ntot = 64 * s.nN, grp = 8 * s.nN;
  const int K = s.K, nt = K / 64, lda = s.lda, akblk = s.akblk;
  const int tbase = (c & 7) * (G >> 3) + (c >> 3);
#define UNIT(i, br, bc) ([&]() -> bool { const int t_ = (i) * G + tbase; if (t_ >= ntot) return false; const int pmg_ = t_ / grp, wi_ = t_ % grp; bc = (wi_ >> 3) * 256; br = (pmg_ * 8 + (wi_ & 7)) * 256; return true; }())
  int brow = 0, bcol = 0, nbrow = 0, nbcol = 0;
  if (!UNIT(0, brow, bcol)) return;
  unsigned voffA[2], voffB[2];
#pragma unroll
  for (int i = 0; i < 2; ++i) { int r, cc; stage_rc(tid * 16 + i * 8192, r, cc); voffA[i] = (unsigned)(r * lda + cc) * 2u; voffB[i] = (unsigned)(r * K + cc) * 2u; }
  const size_t hA = (size_t)128 * lda * 2, hB = (size_t)128 * K * 2;
  const unsigned ldsw = (unsigned)wid * 1024u;
  const int aoff = lds_byte(wr * 64 + fr, fq * 8), boff = lds_byte(wc * 32 + fr, fq * 8);
#define STAGE(bufoff, gbase, voff) do { const char* gb_ = (const char*)(gbase); asm volatile("" : "+s"(gb_));     \
    _Pragma("unroll") for (int i_ = 0; i_ < 2; ++i_) \
    __builtin_amdgcn_global_load_lds((const unsigned*)(gb_ + (voff)[i_]), (LAS unsigned*)(lds + (bufoff) + ldsw + i_ * 8192), 16, 0, 0); } while (0)
#define KA(kt) ((size_t)((((kt) >> 1) * akblk + ((kt) & 1) * 64) * 2))
#define LDA(dst, b, h) _Pragma("unroll") for (int m = 0; m < 4; ++m) _Pragma("unroll") for (int k = 0; k < 2; ++k) \
    dst[m][k] = *(const LAS bf16x8*)(lds + G_SA(b, h) + aoff + m * 2048 + k * 1024)
#define LDB(dst, b, h) _Pragma("unroll") for (int n = 0; n < 2; ++n) _Pragma("unroll") for (int k = 0; k < 2; ++k) \
    dst[n][k] = *(const LAS bf16x8*)(lds + G_SB(b, h) + boff + n * 2048 + k * 1024)
#define MMA(ai, bj, At_, Bt_) do { __builtin_amdgcn_s_setprio(1); \
    _Pragma("unroll") for (int m = 0; m < 4; ++m) _Pragma("unroll") for (int n = 0; n < 2; ++n) _Pragma("unroll") for (int k = 0; k < 2; ++k) \
      acc[ai][bj][m][n] = __builtin_amdgcn_mfma_f32_16x16x32_bf16(Bt_[n][k], At_[m][k], acc[ai][bj][m][n], 0, 0, 0); \
    __builtin_amdgcn_s_setprio(0); } while (0)
#define WAIT_V(n) asm volatile("s_waitcnt vmcnt(" #n ")" ::: "memory")
#define WAIT_L(n) asm volatile("s_waitcnt lgkmcnt(" #n ")" ::: "memory")
#define BAR __builtin_amdgcn_s_barrier()
#define SCHED __builtin_amdgcn_sched_barrier(0)
#define ZERO_ACC() _Pragma("unroll") for (int a_ = 0; a_ < 2; ++a_) _Pragma("unroll") for (int b_ = 0; b_ < 2; ++b_) _Pragma("unroll") for (int m_ = 0; m_ < 4; ++m_) \
    _Pragma("unroll") for (int n_ = 0; n_ < 2; ++n_) acc[a_][b_][m_][n_] = (f32x4){0.f, 0.f, 0.f, 0.f}
#define YG_TABLE(br) do { if (threadIdx.x < 256) { const f32x4* sp = (const f32x4*)(s.f0 + (size_t)((br) + threadIdx.x) * 64); float sh[4]; \
    _Pragma("unroll") for (int hd = 0; hd < 4; ++hd) { const f32x4 a = sp[hd * 4] + sp[hd * 4 + 1] + sp[hd * 4 + 2] + sp[hd * 4 + 3]; sh[hd] = rsqrtf(((a[0] + a[1]) + (a[2] + a[3])) * (1.0f / 256.0f) + 1e-6f); } \
    float* tab = (float*)(smem + 131072); tab[threadIdx.x] = sh[0] / sh[1]; tab[256 + threadIdx.x] = sh[1] / sh[2]; tab[512 + threadIdx.x] = sh[2] / sh[3]; tab[768 + threadIdx.x] = sh[3]; } } while (0)
  f32x4 acc[2][2][4][2];
  ZERO_ACC();
  bf16x8 At[4][2], B0[2][2], B1[2][2];
  const char* cA = (const char*)s.A + (size_t)brow * lda * 2; const char* cB = (const char*)s.Bt + (size_t)bcol * K * 2;
  if (TAB) { YG_TABLE(brow); __syncthreads(); }
  STAGE(G_SB(0, 0), cB, voffB); STAGE(G_SB(0, 1), cB + hB, voffB); STAGE(G_SA(0, 0), cA, voffA); STAGE(G_SA(0, 1), cA + hA, voffA);
  if (wr == 1) BAR;
  WAIT_V(2); BAR;
  STAGE(G_SB(1, 0), cB + 128, voffB); STAGE(G_SA(1, 0), cA + KA(1), voffA); STAGE(G_SB(1, 1), cB + hB + 128, voffB);
  WAIT_V(6); BAR;
  for (int ui = 0;; ++ui) {
    const bool has_next = UNIT(ui + 1, nbrow, nbcol);
    const char* nA = has_next ? (const char*)s.A + (size_t)nbrow * lda * 2 : cA; const char* nB = has_next ? (const char*)s.Bt + (size_t)nbcol * K * 2 : cB;
#pragma nounroll
    for (int t0 = 0; t0 < nt; t0 += (RS ? 4 : 8192)) {
      if (RS && t0 > 0) {
        int fr2 = lane & 15; asm volatile("" : "+v"(fr2));
        const LAS float* rt = (const LAS float*)(lds + 131072) + ((t0 >> 2) - 1) * 256 + wr * 64 + fr2;
#pragma unroll
        for (int ai = 0; ai < 2; ++ai)
#pragma unroll
          for (int m = 0; m < 4; ++m) { const float f = rt[ai * 128 + m * 16];
#pragma unroll
            for (int bj = 0; bj < 2; ++bj)
#pragma unroll
              for (int n = 0; n < 2; ++n) acc[ai][bj][m][n] *= f; }
      }
      const int t1 = RS ? ((t0 + 4 < nt) ? t0 + 4 : nt) : nt;
#pragma nounroll
      for (int t = t0; t < t1; t += 2) {
        const bool last = (t == nt - 2);
        const char* a1 = cA + KA(t + 1);
        const char* a2 = last ? nA : cA + KA(t + 2); const char* b2 = last ? nB : cB + (size_t)(t + 2) * 128;
        const char* a3 = last ? nA + KA(1) : cA + KA(t + 3); const char* b3 = b2 + 128;
        LDB(B0, 0, 0); LDB(B1, 0, 1); SCHED; LDA(At, 0, 0); STAGE(G_SA(1, 1), a1 + hA, voffA);
        WAIT_V(8); WAIT_L(0); BAR; MMA(0, 0, At, B0); MMA(0, 1, At, B1); BAR; SCHED;
        LDA(At, 0, 1); STAGE(G_SB(0, 0), b2, voffB); STAGE(G_SB(0, 1), b2 + hB, voffB); STAGE(G_SA(0, 0), a2, voffA);
        WAIT_V(8); WAIT_L(0); BAR; MMA(1, 0, At, B0); MMA(1, 1, At, B1); BAR; SCHED;
        LDB(B0, 1, 0); LDB(B1, 1, 1); SCHED; LDA(At, 1, 0); STAGE(G_SA(0, 1), a2 + hA, voffA);
        WAIT_V(8); WAIT_L(0); BAR; MMA(0, 0, At, B0); MMA(0, 1, At, B1); BAR; SCHED;
        LDA(At, 1, 1); STAGE(G_SB(1, 0), b3, voffB); STAGE(G_SB(1, 1), b3 + hB, voffB); STAGE(G_SA(1, 0), a3, voffA);
        WAIT_V(8); WAIT_L(0); BAR; MMA(1, 0, At, B0); MMA(1, 1, At, B1); BAR; SCHED;
      }
    }
    if (ALIGN) { if (wr == 0) BAR; }
    { int eb = brow, ec = bcol; asm volatile("" : "+s"(eb), "+s"(ec));
      gemm_epilogue<EPI>(s, acc, eb, ec, ws); }
    if (!has_next) break;
    ZERO_ACC();
    brow = nbrow; bcol = nbcol; cA = nA; cB = nB;
    if (TAB) { BAR; YG_TABLE(brow); asm volatile("s_waitcnt lgkmcnt(0)" ::: "memory"); BAR; if (wr == 1) BAR; }
    else if (ALIGN) { if (wr == 1) BAR; }
  }
  WAIT_V(0);
  if (!ALIGN) { if (wr == 0) BAR; }
  BAR;
#undef UNIT
}

__device__ const double INV_FREQ[32] = {1.0, 0.7498942093324559, 0.5623413251903491, 0.4216965034285823, 0.31622776601683794, 0.23713737056616555, 0.17782794100389226, 0.1333521432163324,
  0.1, 0.07498942093324558, 0.056234132519034905, 0.042169650342858224, 0.03162277660168379, 0.02371373705661655, 0.01778279410038923, 0.01333521432163324,
  0.01, 0.007498942093324559, 0.005623413251903491, 0.004216965034285823, 0.003162277660168379, 0.002371373705661655, 0.001778279410038923, 0.001333521432163324,
  0.001, 0.0007498942093324557, 0.0005623413251903491, 0.0004216965034285823, 0.00031622776601683794, 0.00023713737056616554, 0.00017782794100389227, 0.0001333521432163324};

DI void ln_row2(const float* __restrict__ sa, const float* __restrict__ sb, const float* __restrict__ g, const float* __restrict__ be, bf16_t* oa, bf16_t* ob, float* sta, float* stb, int lane) {
  f32x4 va[4], vb[4]; float s0 = 0.f, s1 = 0.f;
#pragma unroll
  for (int i = 0; i < 4; ++i) va[i] = *(const f32x4*)(sa + 8 * (lane + 64 * (i >> 1)) + 4 * (i & 1));
#pragma unroll
  for (int i = 0; i < 4; ++i) vb[i] = sb ? *(const f32x4*)(sb + 8 * (lane + 64 * (i >> 1)) + 4 * (i & 1)) : (f32x4){0.f, 0.f, 0.f, 0.f};
#pragma unroll
  for (int i = 0; i < 4; ++i) { s0 += (va[i][0] + va[i][1]) + (va[i][2] + va[i][3]); s1 += (vb[i][0] + vb[i][1]) + (vb[i][2] + vb[i][3]); }
  const float mu0 = wave_sum(s0) * (1.0f / 1024.0f), mu1 = wave_sum(s1) * (1.0f / 1024.0f);
  float q0 = 0.f, q1 = 0.f;
#pragma unroll
  for (int i = 0; i < 4; ++i) { const f32x4 d0 = va[i] - mu0, d1 = vb[i] - mu1; q0 += (d0[0] * d0[0] + d0[1] * d0[1]) + (d0[2] * d0[2] + d0[3] * d0[3]); q1 += (d1[0] * d1[0] + d1[1] * d1[1]) + (d1[2] * d1[2] + d1[3] * d1[3]); }
  const float r0 = rsqrtf(wave_sum(q0) * (1.0f / 1024.0f) + 1e-5f), r1 = rsqrtf(wave_sum(q1) * (1.0f / 1024.0f) + 1e-5f);
#pragma unroll
  for (int i = 0; i < 2; ++i) {
    const int c = 8 * (lane + 64 * i);
    const f32x4 g0 = *(const f32x4*)(g + c), g1 = *(const f32x4*)(g + c + 4), b0 = *(const f32x4*)(be + c), b1 = *(const f32x4*)(be + c + 4);
    store_bf8(oa + c, (va[2 * i] - mu0) * r0 * g0 + b0, (va[2 * i + 1] - mu0) * r0 * g1 + b1);
    if (sb) store_bf8(ob + c, (vb[2 * i] - mu1) * r1 * g0 + b0, (vb[2 * i + 1] - mu1) * r1 * g1 + b1);
  }
  if (lane == 0) { sta[0] = mu0; sta[1] = r0; if (sb) { stb[0] = mu1; stb[1] = r1; } }
}

DI int rope_perm_src(int p) { const int a = p >> 5, fq = (p >> 3) & 3, hh = (p >> 2) & 1, i = 16 * a + 4 * fq + (p & 3); return hh * 32 + i; }
DI int colmap(int kind, int n) {
  switch (kind) {
    case 0:
      if (n < 3072) return n;
      if (n < PCKV) return 3088 + (n - PQL);
      if (n < PKR) return 3472 + (n - PCKV);
      if (n < PALR) return 3472 + 256 + rope_perm_src(n - PKR);
      if (n < PALR + 16) return 3072 + (n - PALR);
      return -1;
    case 1: { const int u = n >> 8, w = n & 255, bj = w >> 7, ch = 128 * u + (w & 127); return 3792 + bj * 1024 + ch; }
    case 2: { const int head = n / 192, w = n % 192; return (w < 128) ? head * 192 + w : head * 192 + 128 + rope_perm_src(w - 128); }
    default: return n;
  }
}
struct TileDesc { const float* W; int Nsrc, K; bf16_t* WT; int n0, k0, kind; const float* rowscale; bool perm; };
DI void tile_load(const TileDesc& d, f32x4 (&v)[2], float (&rs)[2]) {
  const int tid = threadIdx.x;
#pragma unroll
  for (int r = 0; r < 2; ++r) {
    const int e = tid + 512 * r, i = e >> 4, j4 = (e & 15) * 4, nd = d.n0 + j4, sc = colmap(d.kind, d.perm ? (nd & ~31) + perm32(nd & 31) : nd);
    v[r] = (f32x4){0.f, 0.f, 0.f, 0.f}; rs[r] = 1.0f;
    if (sc >= 0) { v[r] = *(const f32x4*)(d.W + (size_t)(d.k0 + i) * d.Nsrc + sc); if (d.rowscale) rs[r] = d.rowscale[d.k0 + i]; }
  }
}
DI void tile_finish(const TileDesc& d, const f32x4 (&v)[2], const float (&rs)[2]) {
  float* tile = (float*)smem;
  const int tid = threadIdx.x;
#pragma unroll
  for (int r = 0; r < 2; ++r) {
    const int e = tid + 512 * r, i = e >> 4, j4 = (e & 15) * 4; const f32x4 w = v[r] * rs[r];
    tile[(j4 + 0) * 65 + i] = w[0]; tile[(j4 + 1) * 65 + i] = w[1]; tile[(j4 + 2) * 65 + i] = w[2]; tile[(j4 + 3) * 65 + i] = w[3];
  }
  LBAR();
  { const int j = tid >> 3, i8 = (tid & 7) * 8; const float* tr = tile + j * 65 + i8;
    u32x4 o; o.x = pk2(tr[0], tr[1]); o.y = pk2(tr[2], tr[3]); o.z = pk2(tr[4], tr[5]); o.w = pk2(tr[6], tr[7]);
    *(u32x4*)(d.WT + (size_t)(d.n0 + j) * d.K + d.k0 + i8) = o; }
  LBAR();
}
constexpr int TT0 = 960, TT1 = TT0 + 512, TT2 = TT1 + 144, TT3 = TT2 + 128, TT4 = TT3 + 256, TT5 = TT4 + 256, TT6 = TT5 + 256, TT7 = TT6 + 1024, TT8 = TT7 + 1024;
DI TileDesc tile_desc(const Params& p, int t) {
  unsigned char* ws = p.ws; TileDesc d; d.rowscale = nullptr; d.perm = true; d.kind = 3;
  if (t < TT0) { const int nt = t >> 4, kt = t & 15; d.W = p.w_in; d.Nsrc = DIN; d.K = 1024; d.WT = (bf16_t*)(ws + OFF_WT_IN); d.n0 = nt * 64; d.k0 = kt * 64; d.kind = 0; }
  else if (t < TT1) { const int u = t - TT0, nt = u >> 4, kt = u & 15; d.W = p.w_in; d.Nsrc = DIN; d.K = 1024; d.WT = (bf16_t*)(ws + OFF_WT_G); d.n0 = nt * 64; d.k0 = kt * 64; d.kind = 1; }
  else if (t < TT2) { const int u = t - TT1, nt = u / 6, kt = u % 6; d.W = p.w_q_b; d.Nsrc = 1536; d.K = 384; d.WT = (bf16_t*)(ws + OFF_WT_Q); d.n0 = nt * 64; d.k0 = kt * 64; d.kind = 2; d.rowscale = p.q_a_norm_g; }
  else if (t < TT3) { const int u = t - TT2, nt = u >> 2, kt = u & 3; d.W = p.w_kv_b; d.Nsrc = 2048; d.K = 256; d.WT = (bf16_t*)(ws + OFF_WT_KV); d.n0 = nt * 64; d.k0 = kt * 64; d.rowscale = p.kv_a_norm_g; }
  else if (t < TT4) { const int u = t - TT3, nt = u >> 4, kt = u & 15; d.W = p.w_o_gla; d.Nsrc = 1024; d.K = 1024; d.WT = (bf16_t*)(ws + OFF_WT_OG); d.n0 = nt * 64; d.k0 = kt * 64; d.rowscale = p.gla_norm_g; }
  else if (t < TT5) { const int u = t - TT4, nt = u >> 4, kt = u & 15; d.W = p.w_o_mla; d.Nsrc = 1024; d.K = 1024; d.WT = (bf16_t*)(ws + OFF_WT_OM); d.n0 = nt * 64; d.k0 = kt * 64; }
  else if (t < TT6) { const int u = t - TT5, nt = u >> 4, kt = u & 15; d.W = p.w_out; d.Nsrc = 1024; d.K = 1024; d.WT = (bf16_t*)(ws + OFF_WT_OUT); d.n0 = nt * 64; d.k0 = kt * 64; d.perm = false; }
  else if (t < TT7) { const int u = t - TT6, nt = u >> 4, kt = u & 15; d.W = p.w_ff1; d.Nsrc = 4096; d.K = 1024; d.WT = (bf16_t*)((unsigned char*)p.out + OOFF_WT_FF1); d.n0 = nt * 64; d.k0 = kt * 64; }
  else { const int u = t - TT7, nt = u >> 6, kt = u & 63; d.W = p.w_ff2; d.Nsrc = 1024; d.K = 4096; d.WT = (bf16_t*)(ws + OFF_WT_FF2); d.n0 = nt * 64; d.k0 = kt * 64; d.perm = false; }
  return d;
}
template <int MODE>
DI void ln_row(const float* __restrict__ src, const float* __restrict__ g, const float* __restrict__ be, bf16_t* obf, float* of32, float* st, int lane) {
  f32x4 v[4]; float s = 0.f;
#pragma unroll
  for (int i = 0; i < 4; ++i) { v[i] = *(const f32x4*)(src + 8 * (lane + 64 * (i >> 1)) + 4 * (i & 1)); s += (v[i][0] + v[i][1]) + (v[i][2] + v[i][3]); }
  const float mu = wave_sum(s) * (1.0f / 1024.0f);
  float q = 0.f;
#pragma unroll
  for (int i = 0; i < 4; ++i) { const f32x4 dlt = v[i] - mu; q += (dlt[0] * dlt[0] + dlt[1] * dlt[1]) + (dlt[2] * dlt[2] + dlt[3] * dlt[3]); }
  const float rs = rsqrtf(wave_sum(q) * (1.0f / 1024.0f) + 1e-5f);
#pragma unroll
  for (int i = 0; i < 2; ++i) {
    const int c = 8 * (lane + 64 * i);
    const f32x4 o0 = (v[2 * i] - mu) * rs * *(const f32x4*)(g + c) + *(const f32x4*)(be + c), o1 = (v[2 * i + 1] - mu) * rs * *(const f32x4*)(g + c + 4) + *(const f32x4*)(be + c + 4);
    if (MODE == 0) store_bf8(obf + c, o0, o1); else { *(f32x4*)(of32 + c) = o0; *(f32x4*)(of32 + c + 4) = o1; }
  }
  if (MODE == 0 && lane == 0) { st[0] = mu; st[1] = rs; }
}

DI void phase_prologue(const Params& p) {
  unsigned char* ws = p.ws;
  const int tid = threadIdx.x, wid = tid >> 6, lane = tid & 63, G = gridDim.x;
  for (int row = blockIdx.x * 8 + wid; row < M_TOK; row += G * 16) {
    const int row2 = row + G * 8;
    ln_row2(p.x + (size_t)row * 1024, row2 < M_TOK ? p.x + (size_t)row2 * 1024 : nullptr, p.ln_in_g, p.ln_in_b, (bf16_t*)(ws + OFF_H0) + (size_t)row * 1024, (bf16_t*)(ws + OFF_H0) + (size_t)row2 * 1024,
            (float*)(ws + OFF_ST0) + 2 * row, (float*)(ws + OFF_ST0) + 2 * row2, lane);
  }
  for (int idx = blockIdx.x * 512 + tid; idx < M_TOK * 2; idx += G * 512) ((float*)((unsigned char*)p.out + OOFF_RSS))[idx] = 0.f;
  for (int idx = blockIdx.x * 512 + tid; idx < M_TOK * 32; idx += G * 512) {
    const int row = idx >> 5, i = idx & 31;
    const double ang = (double)p.pos[row] * INV_FREQ[i];
    const double n = __builtin_rint(ang * 0.15915494309189535);
    const float r = (float)(ang - n * 6.283185307179586);
    ((float*)(ws + OFF_COS))[idx] = cosf(r); ((float*)(ws + OFF_SIN))[idx] = sinf(r);
  }
  { int t = blockIdx.x;
    if (t < TT8) {
      TileDesc d0 = tile_desc(p, t); f32x4 va[2]; float ra[2]; tile_load(d0, va, ra);
      while (true) {
        const int tn = t + G; const bool more = tn < TT8;
        TileDesc d1 = d0; f32x4 vb[2] = {va[0], va[1]}; float rb[2] = {ra[0], ra[1]};
        if (more) { d1 = tile_desc(p, tn); tile_load(d1, vb, rb); }
        tile_finish(d0, va, ra);
        if (!more) break;
        t = tn; d0 = d1; va[0] = vb[0]; va[1] = vb[1]; ra[0] = rb[0]; ra[1] = rb[1];
      }
    }
  }
}

#define MFMA32(a, b, c) __builtin_amdgcn_mfma_f32_32x32x16_bf16((a), (b), (c), 0, 0, 0)
constexpr int KROW = 400, VROW = 320;
constexpr int KBUF = 64 * KROW, VBUF = 64 * VROW;
DI int crow(int i, int h) { return (i & 3) + 8 * (i >> 2) + 4 * h; }

DI void attn_item(const Params& p, int b, int h, int qb, bool dry) {
  unsigned char* ws = p.ws;
  const bf16_t* Pm = (const bf16_t*)(ws + OFF_P);
  const bf16_t* KN = (const bf16_t*)(ws + OFF_KN);
  const bf16_t* VT = (const bf16_t*)(ws + OFF_VT);
  bf16_t* Q = (bf16_t*)((unsigned char*)p.out + OOFF_Q);
  const int tid = threadIdx.x, wid = tid >> 6, lane = tid & 63, l31 = lane & 31, hh = lane >> 5;
  const int q0 = qb * 256, nkt = 4 * (qb + 1);
  const int qrow = q0 + 32 * wid + l31;
  const int last_kt = (q0 + 32 * wid + 31) >> 6;
  unsigned char* Kb = smem; unsigned char* Vb = smem + 2 * KBUF;
  bf16x8 qf[12];
  { LAS unsigned char* qt = (LAS unsigned char*)smem + wid * (32 * 400);
    const bf16_t* qg = Q + (unsigned)((b * 2048 + q0 + 32 * wid + (lane >> 3)) * QW + h * 192 + (lane & 7) * 8);
    LAS unsigned char* qw = qt + (lane >> 3) * 400 + (lane & 7) * 16;
#pragma unroll
    for (int ri = 0; ri < 4; ++ri) {
#pragma unroll
      for (int cj = 0; cj < 3; ++cj) *(LAS u32x4*)(qw + ri * 3200 + cj * 128) = *(const u32x4*)(qg + ri * 8 * QW + cj * 64);
      asm volatile("" ::: "memory");
    }
    asm volatile("s_waitcnt lgkmcnt(0)" ::: "memory");
    { const LAS unsigned char* qr = qt + l31 * 400 + 16 * hh;
#pragma unroll
      for (int ks = 0; ks < 12; ++ks) qf[ks] = *(const LAS bf16x8*)(qr + 32 * ks); }
    LBAR();
  }
  u32x4 kreg[3], vreg[2];
  unsigned kofs[3], vofs[2];
#pragma unroll
  for (int i = 0; i < 3; ++i) { const int e = tid + 512 * i, key = e / 24, cc = e % 24; const unsigned tok = (unsigned)(b * 2048 + key);
    kofs[i] = (cc < 16) ? (unsigned)OFF_KN + (tok * 1024u + h * 128 + cc * 8) * 2u : (unsigned)OFF_P + (tok * (unsigned)NP + PKR + (cc - 16) * 8) * 2u; }
#pragma unroll
  for (int i = 0; i < 2; ++i) { const int e = tid + 512 * i, key = e >> 4, cc = e & 15; vofs[i] = (unsigned)OFF_VT + ((unsigned)(b * 2048 + key) * 1024u + h * 128 + cc * 8) * 2u; }
  auto gload = [&](int) {
#pragma unroll
    for (int i = 0; i < 3; ++i) { kreg[i] = *(const u32x4*)(ws + kofs[i]); kofs[i] += ((tid + 512 * i) % 24 < 16) ? 64u * 2048u : 64u * (unsigned)(NP * 2); }
#pragma unroll
    for (int i = 0; i < 2; ++i) { vreg[i] = *(const u32x4*)(ws + vofs[i]); vofs[i] += 64u * 2048u; }
  };
  int klds[3], vlds[2];
#pragma unroll
  for (int i = 0; i < 3; ++i) { const int e = tid + 512 * i, key = e / 24, cc = e % 24; klds[i] = key * KROW + cc * 16; }
#pragma unroll
  for (int i = 0; i < 2; ++i) { const int e = tid + 512 * i, key = e >> 4, cc = e & 15; vlds[i] = key * VROW + cc * 16; }
  auto lstore = [&](int buf) {
#pragma unroll
    for (int i = 0; i < 3; ++i) *(u32x4*)(Kb + buf * KBUF + klds[i]) = kreg[i];
#pragma unroll
    for (int i = 0; i < 2; ++i) *(u32x4*)(Vb + buf * VBUF + vlds[i]) = vreg[i];
  };
  f32x16 o[4];
#pragma unroll
  for (int t = 0; t < 4; ++t)
#pragma unroll
    for (int i = 0; i < 16; ++i) o[t][i] = 0.f;
  float mrun = -1e30f, lrun = 0.f;
  gload(0); lstore(0); gload(1); LBAR();
  for (int kt = 0; kt < nkt; ++kt) {
    if (kt + 1 < nkt) lstore((kt + 1) & 1);
    if (kt + 2 < nkt) gload(kt + 2);
    if (kt <= last_kt) {
      const unsigned char* kb = Kb + (kt & 1) * KBUF + l31 * KROW + 16 * hh;
      const unsigned char* vb = Vb + (kt & 1) * VBUF + (4 * hh + ((lane & 15) >> 2)) * VROW + 32 * ((lane >> 4) & 1) + 8 * (lane & 3);
      f32x16 s0, s1;
#pragma unroll
      for (int i = 0; i < 16; ++i) { s0[i] = 0.f; s1[i] = 0.f; }
#pragma unroll
      for (int ks = 0; ks < 12; ++ks) {
        const bf16x8 a0 = *(const bf16x8*)(kb + 32 * ks), a1 = *(const bf16x8*)(kb + 32 * KROW + 32 * ks);
        s0 = MFMA32(a0, qf[ks], s0); s1 = MFMA32(a1, qf[ks], s1);
      }
      if (64 * kt + 63 > q0 + 32 * wid) {
#pragma unroll
        for (int i = 0; i < 16; ++i) { const int key = 64 * kt + crow(i, hh);
          if (key > qrow) s0[i] = -1e30f;
          if (key + 32 > qrow) s1[i] = -1e30f; }
      }
      float mx = s0[0];
#pragma unroll
      for (int i = 1; i < 16; ++i) mx = fmaxf(mx, s0[i]);
#pragma unroll
      for (int i = 0; i < 16; ++i) mx = fmaxf(mx, s1[i]);
      mx = xor32_max(mx);
      if (!__all(mx - mrun <= 8.0f)) {
        const float mnew = fmaxf(mrun, mx), alpha = __builtin_amdgcn_exp2f(mrun - mnew);
        mrun = mnew; lrun *= alpha;
#pragma unroll
        for (int t = 0; t < 4; ++t)
#pragma unroll
          for (int i = 0; i < 16; ++i) o[t][i] *= alpha;
      }
      float ps = 0.f;
#pragma unroll
      for (int i = 0; i < 16; ++i) { s0[i] = __builtin_amdgcn_exp2f(s0[i] - mrun); s1[i] = __builtin_amdgcn_exp2f(s1[i] - mrun); ps += s0[i] + s1[i]; }
      lrun += ps;
#pragma unroll
      for (int kh = 0; kh < 2; ++kh)
#pragma unroll
        for (int s2 = 0; s2 < 2; ++s2) {
          u32x4 pw;
#pragma unroll
          for (int j = 0; j < 4; ++j) pw[j] = kh ? pk2(s1[8 * s2 + 2 * j], s1[8 * s2 + 2 * j + 1]) : pk2(s0[8 * s2 + 2 * j], s0[8 * s2 + 2 * j + 1]);
          const bf16x8 pf = __builtin_bit_cast(bf16x8, pw);
#pragma unroll
          for (int t = 0; t < 4; ++t) {
            const unsigned char* va = vb + (32 * kh + 16 * s2) * VROW + 64 * t;
            const s16x4 lo = __builtin_amdgcn_ds_read_tr16_b64_v4i16((LAS s16x4*)va), hi = __builtin_amdgcn_ds_read_tr16_b64_v4i16((LAS s16x4*)(va + 8 * VROW));
            o[t] = MFMA32(__builtin_shufflevector(lo, hi, 0, 1, 2, 3, 4, 5, 6, 7), pf, o[t]);
          }
        }
    }
    LBAR();
  }
  const float inv = 1.0f / xor32_sum(lrun);
  { int t2 = threadIdx.x; asm volatile("" : "+v"(t2)); const int lane = t2 & 63, wid = t2 >> 6, l31 = lane & 31, hh = lane >> 5;
    LAS unsigned char* ot = (LAS unsigned char*)smem + wid * (32 * 272);
    LAS unsigned char* ow = ot + l31 * 272 + 8 * hh;
#pragma unroll
    for (int t = 0; t < 4; ++t)
#pragma unroll
      for (int g4 = 0; g4 < 4; ++g4) {
        const f32x4 v = {o[t][4 * g4] * inv, o[t][4 * g4 + 1] * inv, o[t][4 * g4 + 2] * inv, o[t][4 * g4 + 3] * inv};
        *(LAS u32x2*)(ow + (32 * t + 8 * g4) * 2) = pk4(v);
      }
    asm volatile("s_waitcnt lgkmcnt(0)" ::: "memory");
    const LAS unsigned char* orp = ot + (lane >> 4) * 272 + (lane & 15) * 16;
    const unsigned goff = dry ? (unsigned)threadIdx.x * 512u : (unsigned)((b * 2048 + q0 + 32 * wid + (lane >> 4)) * QW + h * 192 + (lane & 15) * 8);
    bf16_t* gb = dry ? (bf16_t*)((unsigned char*)p.out + OOFF_DUMMY) : Q;
#pragma unroll
    for (int i = 0; i < 8; ++i) *(u32x4*)(gb + goff + (dry ? 8u * i : (unsigned)(4 * i * QW))) = *(const LAS u32x4*)(orp + 4 * i * 272);
  }
  LBAR();
}

#define MFMA16(a, b, c) __builtin_amdgcn_mfma_f32_16x16x32_bf16((a), (b), (c), 0, 0, 0)
constexpr int GP_RQ = 0, GP_RK = GP_RQ + 64 * 272, GP_QB = GP_RK + 64 * 272, GP_KB = GP_QB + 64 * 272, GP_ALR = GP_KB + 64 * 272, GP_TOT = GP_ALR + 64 * 16 * 4, GP_END = GP_TOT + 4 * 128 * 4;
static_assert(GP_END <= LDS_BYTES, "gla pre lds");

template <bool DRY>
DI void gla_pre_item(const Params& p, int item) {
  unsigned char* ws = p.ws;
  bf16_t* Pm = (bf16_t*)(ws + OFF_P);
  bf16_t* ASg = (bf16_t*)(ws + OFF_AS);
  float* EBLg = (float*)((unsigned char*)p.out + OOFF_EBL);
  const int c = item & 31, h = (item >> 5) & 3, b = item >> 7;
  const int tid = threadIdx.x, wid = tid >> 6, lane = tid & 63, fr = lane & 15, fq = lane >> 4;
  const int d = tid & 127, rg = tid >> 7;
  const size_t rb = (size_t)(b * 2048 + 64 * c);
  float* ALR = (float*)(smem + GP_ALR); float* TOT = (float*)(smem + GP_TOT);
#pragma unroll
  for (int i = 0; i < 2; ++i) { const int e = tid + 512 * i, row = e >> 4, cc = e & 15; const bf16_t* src = Pm + (rb + row) * NP + h * 128 + cc * 8;
    *(u32x4*)(smem + GP_RQ + row * 272 + cc * 16) = *(const u32x4*)(src + PQG); *(u32x4*)(smem + GP_RK + row * 272 + cc * 16) = *(const u32x4*)(src + PKG); }
  { const int vj = tid >> 3, ar2 = (tid & 7) * 2; const unsigned av = *(const unsigned*)(Pm + (rb + vj) * NP + PALR + ar2); ALR[vj * 16 + ar2] = bflo(av); ALR[vj * 16 + ar2 + 1] = bfhi(av); }
  float w2c[16];
#pragma unroll
  for (int r = 0; r < 16; ++r) w2c[r] = p.w_gla_a2[r * 512 + h * 128 + d];
  const float b2 = p.b_gla_a2[h * 128 + d];
  LBAR();
  float cum[16]; float run = 0.f;
#pragma unroll
  for (int i = 0; i < 16; ++i) {
    const float* ar = ALR + (16 * rg + i) * 16;
    float z = b2;
#pragma unroll
    for (int r = 0; r < 16; ++r) z += ar[r] * w2c[r];
    const float ls = fminf(z, 0.f) - __logf(1.0f + __expf(-fabsf(z)));
    run += ls * (1.0f / 16.0f); cum[i] = run;
  }
  TOT[rg * 128 + d] = run;
  LBAR();
  float off = 0.f, blast = 0.f;
#pragma unroll
  for (int g = 0; g < 4; ++g) { const float tv = TOT[g * 128 + d]; blast += tv; if (g < rg) off += tv; }
  { const bf16_t* RQ = (const bf16_t*)(smem + GP_RQ); const bf16_t* RK = (const bf16_t*)(smem + GP_RK);
    bf16_t* QB = (bf16_t*)(smem + GP_QB); bf16_t* KB = (bf16_t*)(smem + GP_KB);
    unsigned kd[8];
#pragma unroll
    for (int i = 0; i < 16; i += 2) {
      const int r0 = 16 * rg + i;
      const float b0 = off + cum[i], b1 = off + cum[i + 1];
      const float q0 = bf2f(RQ[r0 * 136 + d]), q1 = bf2f(RQ[(r0 + 1) * 136 + d]), k0 = bf2f(RK[r0 * 136 + d]), k1 = bf2f(RK[(r0 + 1) * 136 + d]);
      const bf16_t qb0 = f2bf(q0 * __expf(b0) * GLA_QS), qb1 = f2bf(q1 * __expf(b1) * GLA_QS);
      QB[r0 * 136 + d] = qb0; QB[(r0 + 1) * 136 + d] = qb1;
      KB[r0 * 136 + d] = f2bf(k0 * __expf(-b0)); KB[(r0 + 1) * 136 + d] = f2bf(k1 * __expf(-b1));
      kd[i >> 1] = pk2(k0 * __expf(blast - b0), k1 * __expf(blast - b1));
    }
    u32x4* kdt = DRY ? (u32x4*)((unsigned char*)p.out + OOFF_DUMMY + tid * 32) : (u32x4*)(Pm + (rb + (d >> 1)) * NP + PKG + h * 128 + (d & 1) * 64 + 16 * rg);
    kdt[0] = (u32x4){kd[0], kd[1], kd[2], kd[3]}; kdt[1] = (u32x4){kd[4], kd[5], kd[6], kd[7]};
    if (rg == 0 && !DRY) EBLg[item * 128 + d] = __expf(blast);
  }
  LBAR();
#pragma unroll
  for (int i = 0; i < 2; ++i) { const int e = tid + 512 * i, row = e >> 4, cc = e & 15;
    bf16_t* dst = DRY ? (bf16_t*)((unsigned char*)p.out + OOFF_DUMMY) + e * 8 : Pm + (rb + row) * NP + PQG + h * 128 + cc * 8;
    *(u32x4*)dst = *(const u32x4*)(smem + GP_QB + row * 272 + cc * 16); }
  { const int ti = wid >> 1, tv = wid & 1;
    const unsigned char* qa = smem + GP_QB + (16 * ti + fr) * 272 + 16 * fq;
    bf16x8 qfr[4];
#pragma unroll
    for (int ks = 0; ks < 4; ++ks) qfr[ks] = *(const bf16x8*)(qa + 64 * ks);
#pragma unroll
    for (int x = 0; x < 2; ++x) {
      const int tj = 2 * tv + x;
      f32x4 sa = {0.f, 0.f, 0.f, 0.f};
      if (tj <= ti) {
        const unsigned char* ka = smem + GP_KB + (16 * tj + fr) * 272 + 16 * fq;
#pragma unroll
        for (int ks = 0; ks < 4; ++ks) sa = MFMA16(qfr[ks], *(const bf16x8*)(ka + 64 * ks), sa);
        if (tj == ti) {
#pragma unroll
          for (int e = 0; e < 4; ++e) if (fr > 4 * fq + e) sa[e] = 0.f;
        }
      }
#pragma unroll
      for (int e = 0; e < 4; ++e) ((bf16_t*)(smem + GP_RQ))[(16 * ti + 4 * fq + e) * 72 + 16 * tj + fr] = f2bf(sa[e]);
    }
  }
  LBAR();
  { bf16_t* dst = DRY ? (bf16_t*)((unsigned char*)p.out + OOFF_DUMMY) + 0x40000 + tid * 8 : ASg + (size_t)item * 4096 + (tid >> 3) * 64 + (tid & 7) * 8;
    *(u32x4*)dst = *(const u32x4*)(smem + GP_RQ + (tid >> 3) * 144 + (tid & 7) * 16); }
  LBAR();
}

constexpr int GS_QB = 0, GS_KDT = GS_QB + 64 * 272, GS_AS = GS_KDT + 128 * 144, GS_VT = GS_AS + 64 * 144, GS_EBL = GS_VT + 32 * 144, GS_BUF = GS_EBL + 512;
constexpr int GS_SB = 2 * GS_BUF, GS_END = GS_SB + 2 * 32 * 272;
static_assert(GS_END <= LDS_BYTES, "gla scan lds");

struct GlaRegs { u32x4 qb[2], kd[2], as, v; float ebl; bf16_t rr[4]; };

DI void gla_scan_item(const Params& p, int b, int h, int s8, bool dry) {
  unsigned char* ws = p.ws;
  bf16_t* Pm = (bf16_t*)(ws + OFF_P);
  const bf16_t* ASg = (const bf16_t*)(ws + OFF_AS);
  const float* EBLg = (const float*)((unsigned char*)p.out + OOFF_EBL);
  float* SSQ = (float*)((unsigned char*)p.out + OOFF_SSQ);
  const int tid = threadIdx.x, wid = tid >> 6, lane = tid & 63, fr = lane & 15, fq = lane >> 4;
  const int ti = wid >> 1, tv = wid & 1;
  const int vcol = PVG + h * 256 + s8 * 32, rcol = PRG + h * 256 + s8 * 32;
  const int item0 = (b * 4 + h) * 32;
  for (int e = tid; e < 2 * 32 * 272 / 4; e += 512) ((unsigned*)(smem + GS_SB))[e] = 0u;
  f32x4 st[2] = {{0.f, 0.f, 0.f, 0.f}, {0.f, 0.f, 0.f, 0.f}};
  unsigned oqb[2], okd[2], oas, ov, oeb, orr[4];
#pragma unroll
  for (int i = 0; i < 2; ++i) { const int e = tid + 512 * i;
    { const int row = e >> 4, cc = e & 15; oqb[i] = (unsigned)OFF_P + ((unsigned)(b * 2048 + row) * (unsigned)NP + PQG + h * 128 + cc * 8) * 2u; }
    { const int dk = e >> 3, j8 = e & 7; okd[i] = (unsigned)OFF_P + ((unsigned)(b * 2048 + (dk >> 1)) * (unsigned)NP + PKG + h * 128 + (dk & 1) * 64 + j8 * 8) * 2u; } }
  oas = (unsigned)OFF_AS + ((unsigned)item0 * 4096u + tid * 8) * 2u;
  ov = (unsigned)OFF_P + ((unsigned)(b * 2048 + (tid >> 2)) * (unsigned)NP + vcol + (tid & 3) * 8) * 2u;
  oeb = (unsigned)(item0 * 128 + (tid & 127)) * 4u;
#pragma unroll
  for (int e = 0; e < 4; ++e) orr[e] = (unsigned)OFF_P + ((unsigned)(b * 2048 + 16 * ti + 4 * fq + e) * (unsigned)NP + rcol + 16 * tv + fr) * 2u;
  auto gload = [&](GlaRegs& R, int) {
    constexpr unsigned CH = 64u * (unsigned)NP * 2u;
#pragma unroll
    for (int i = 0; i < 2; ++i) { R.qb[i] = *(const u32x4*)(ws + oqb[i]); oqb[i] += CH; R.kd[i] = *(const u32x4*)(ws + okd[i]); okd[i] += CH; }
    R.as = *(const u32x4*)(ws + oas); oas += 8192u;
    if (tid < 256) R.v = *(const u32x4*)(ws + ov);
    ov += CH;
    if (tid < 128) R.ebl = *(const float*)((const unsigned char*)EBLg + oeb);
    oeb += 512u;
#pragma unroll
    for (int e = 0; e < 4; ++e) { R.rr[e] = *(const bf16_t*)(ws + orr[e]); orr[e] += CH; }
  };
  auto lstore = [&](const GlaRegs& R, int buf) {
    unsigned char* B = smem + buf * GS_BUF;
#pragma unroll
    for (int i = 0; i < 2; ++i) { const int e = tid + 512 * i;
      { const int row = e >> 4, cc = e & 15; *(u32x4*)(B + GS_QB + row * 272 + cc * 16) = R.qb[i]; }
      { const int dk = e >> 3, j8 = e & 7; *(u32x4*)(B + GS_KDT + dk * 144 + j8 * 16) = R.kd[i]; } }
    *(u32x4*)(B + GS_AS + (tid >> 3) * 144 + (tid & 7) * 16) = R.as;
    if (tid < 256) { bf16_t* vt = (bf16_t*)(B + GS_VT); const int j = tid >> 2, c8 = (tid & 3) * 8;
#pragma unroll
      for (int e = 0; e < 4; ++e) { vt[(c8 + 2 * e) * 72 + j] = (bf16_t)(R.v[e] & 0xffffu); vt[(c8 + 2 * e + 1) * 72 + j] = (bf16_t)(R.v[e] >> 16); } }
    if (tid < 128) ((float*)(B + GS_EBL))[tid] = R.ebl;
  };
  auto compute = [&](int c, const bf16_t (&rr)[4]) {
    const unsigned char* B = smem + (c & 1) * GS_BUF;
    const unsigned char* SBr = smem + GS_SB + (c & 1) * (32 * 272);
    bf16_t* SBw = (bf16_t*)(smem + GS_SB + ((c + 1) & 1) * (32 * 272));
    const size_t rb = (size_t)(b * 2048 + 64 * c);
    f32x4 oacc = {0.f, 0.f, 0.f, 0.f};
    { const unsigned char* qa = B + GS_QB + (16 * ti + fr) * 272 + 16 * fq;
      const unsigned char* sb = SBr + (16 * tv + fr) * 272 + 16 * fq;
#pragma unroll
      for (int ks = 0; ks < 4; ++ks) oacc = MFMA16(*(const bf16x8*)(qa + 64 * ks), *(const bf16x8*)(sb + 64 * ks), oacc); }
    const unsigned char* aa = B + GS_AS + (16 * ti + fr) * 144 + 16 * fq;
    const unsigned char* vb = B + GS_VT + (16 * tv + fr) * 144 + 16 * fq;
    bf16x8 vfr[2];
#pragma unroll
    for (int ks = 0; ks < 2; ++ks) { vfr[ks] = *(const bf16x8*)(vb + 64 * ks); oacc = MFMA16(*(const bf16x8*)(aa + 64 * ks), vfr[ks], oacc); }
#pragma unroll
    for (int e = 0; e < 4; ++e) {
      const float o = oacc[e], r = bf2f(rr[e]);
      float sq = o * o;
      sq = row16_sum(sq);
      const size_t row = rb + 16 * ti + 4 * fq + e;
      bf16_t* od = dry ? (bf16_t*)((unsigned char*)p.out + OOFF_DUMMY) + threadIdx.x * 8 + e : Pm + row * NP + vcol + 16 * tv + fr;
      *od = f2bf(o * r * sigmoidf_(r));
      if (fr == 0 && !dry) SSQ[(row * 4 + h) * 16 + s8 * 2 + tv] = sq;
    }
    const float* EBL = (const float*)(B + GS_EBL);
#pragma unroll
    for (int x = 0; x < 2; ++x) {
      const int tk = 2 * ti + x;
      const float dec = EBL[16 * tk + fr];
      st[x] = st[x] * dec;
      const unsigned char* kb = B + GS_KDT + (16 * tk + fr) * 144 + 16 * fq;
#pragma unroll
      for (int ks = 0; ks < 2; ++ks) st[x] = MFMA16(vfr[ks], *(const bf16x8*)(kb + 64 * ks), st[x]);
#pragma unroll
      for (int e = 0; e < 4; ++e) SBw[(16 * tv + 4 * fq + e) * 136 + 16 * tk + fr] = f2bf(st[x][e]);
    }
  };
  GlaRegs R0, R1;
  gload(R0, 0); gload(R1, 1);
  lstore(R0, 0);
  bf16_t rc[4];
#pragma unroll
  for (int e = 0; e < 4; ++e) rc[e] = R0.rr[e];
  LBAR();
#pragma nounroll
  for (int c = 0; c < 32; c += 2) {
    if (c + 2 < 32) gload(R0, c + 2);
    compute(c, rc);
    lstore(R1, 1);
#pragma unroll
    for (int e = 0; e < 4; ++e) rc[e] = R1.rr[e];
    LBAR();
    if (c + 3 < 32) gload(R1, c + 3);
    compute(c + 1, rc);
    if (c + 2 < 32) { lstore(R0, 0);
#pragma unroll
      for (int e = 0; e < 4; ++e) rc[e] = R0.rr[e]; }
    LBAR();
  }
}

template <bool DRY>
DI void run_attn(const Params& p) {
  const int c = blockIdx.x, G = gridDim.x;
  for (int r = 0; r * G < 512; ++r) {
    const int si = (r & 1) ? ((r + 1) * G - 1 - c) : (r * G + c);
    if (si < 512) { const int qb = 7 - (si >> 6), bh = si & 63; attn_item(p, bh >> 3, bh & 7, qb, DRY); }
  }
}
template <bool DRY>
DI void run_gla(const Params& p) {
  const int c = blockIdx.x, G = gridDim.x;
  for (int it0 = c; it0 < 256; it0 += G) { const int it = (G == 256) ? ((c & 7) * 32 + (c >> 3)) : it0; gla_scan_item(p, it >> 5, (it >> 3) & 3, it & 7, DRY); }
}
DI void phase_mixers(const Params& p) {
#if PROBE_ATTN2
  run_attn<true>(p);
#endif
  run_attn<false>(p);
#if PROBE_GLA2
  run_gla<true>(p);
#endif
  run_gla<false>(p);
}

#define XB_TMO      128
#define XB_XCNT(j)  (256  + 64 * (j))
#define XB_XSUB(j)  (1280 + 64 * (j))
#define XB_XGEN(j)  (2304 + 64 * (j))
#define XB_TOP      3328
#define XB_TOPGEN   3392
#define XB_SPIN_CAP (1u << 22)
__shared__ unsigned g_xb_st[4];
#define XB_SPIN(cond, bar) do { unsigned _sp = 0; while (cond) { __builtin_amdgcn_s_sleep(1); \
    if ((++_sp & 255u) == 0u) { if (xb_ld(&(bar)[XB_TMO])) break; if (_sp > XB_SPIN_CAP) { atomicAdd(&(bar)[XB_TMO], 1u); break; } } } } while (0)
DI void xcd_barrier_post(unsigned* bar) {
  if (threadIdx.x == 0) { const unsigned x = (unsigned)__builtin_amdgcn_s_getreg((3 << 11) | 20) & 0xFu; g_xb_st[0] = 0u; g_xb_st[1] = 0u; g_xb_st[2] = x; (void)xb_add(&bar[XB_XCNT(x)], 1u); }
  __syncthreads();
}
DI void xcd_barrier(unsigned* bar) {
  asm volatile("s_waitcnt vmcnt(0)" ::: "memory");
  __syncthreads();
  if (threadIdx.x == 0) {
    __builtin_amdgcn_s_waitcnt(0);
    volatile unsigned* st = g_xb_st;
    unsigned nloc = st[0], nx = st[1]; const unsigned x = st[2];
    if (nloc == 0u) {
      const unsigned G = gridDim.x; unsigned sum, cnt, mine, sp = 0u;
      for (;;) {
        sum = 0u; cnt = 0u; mine = 0u;
        for (unsigned j = 0; j < 16; ++j) { const unsigned c = xb_ld(&bar[XB_XCNT(j)]); sum += c; cnt += (c > 0u) ? 1u : 0u; mine = (j == x) ? c : mine; }
        if (sum == G) break;
        __builtin_amdgcn_s_sleep(1);
        if ((++sp & 255u) == 0u) { if (xb_ld(&bar[XB_TMO])) break; if (sp > XB_SPIN_CAP) { atomicAdd(&bar[XB_TMO], 1u); break; } }
      }
      nloc = mine > 0u ? mine : 1u; nx = cnt > 0u ? cnt : 1u; st[0] = nloc; st[1] = nx;
    }
    const unsigned old = xb_add(&bar[XB_XSUB(x)], 1u);
    const unsigned gen = old / nloc;
    if (old + 1u == (gen + 1u) * nloc) {
      __builtin_amdgcn_fence(__ATOMIC_RELEASE, "agent");
      asm volatile("s_waitcnt vmcnt(0)" ::: "memory");
      const unsigned og = xb_add(&bar[XB_TOP], 1u);
      const unsigned tg = og / nx;
      if (og + 1u == (tg + 1u) * nx) xb_add(&bar[XB_TOPGEN], 1u);
      else XB_SPIN(xb_ld(&bar[XB_TOPGEN]) == tg, bar);
      __builtin_amdgcn_fence(__ATOMIC_ACQUIRE, "agent");
      xb_add(&bar[XB_XGEN(x)], 1u);
      asm volatile("s_waitcnt vmcnt(0)" ::: "memory");
    } else {
      XB_SPIN(xb_ld(&bar[XB_XGEN(x)]) == gen, bar);
      __builtin_amdgcn_fence(__ATOMIC_ACQUIRE, "agent");
      asm volatile("s_waitcnt vmcnt(0)" ::: "memory");
    }
  }
  __syncthreads();
}

DI Sub make_sub(const void* A, int lda, int akblk, const void* Bt, int K, int nN, void* o0, void* o1, int ldo) {
  Sub z; z.A = (const bf16_t*)A; z.lda = lda; z.akblk = akblk; z.Bt = (const bf16_t*)Bt; z.K = K; z.nN = nN; z.epi = 0; z.rsK = 0; z.o0 = o0; z.o1 = o1; z.ldo = ldo;
  z.f0 = z.f1 = z.f2 = z.f3 = nullptr; z.b0 = z.b1 = nullptr; z.sums = nullptr; z.cnt = nullptr; z.g2 = z.be2 = nullptr; z.st_out = nullptr; return z;
}

__global__ void __launch_bounds__(512) mega(Params p) {
  cg::grid_group grid = cg::this_grid();
  unsigned char* ws = p.ws;
  unsigned char* ob = (unsigned char*)p.out;
  const int lo = p.ph_lo, hi = p.ph_hi;
  unsigned* bar = (unsigned*)(ws + OFF_BAR);
  if (lo < 0) grid.sync();
  xcd_barrier_post(bar);
#define GSYNC() xcd_barrier(bar)
#define PHASE(n) if (lo <= (n) && (n) < hi && (((n) > lo) ? (GSYNC(), true) : true))
#define DUP(n) if ((PROBE_DUP >> (n)) & 1)
#define RUN(n, ...) PHASE(n) { { constexpr int rep_ = 0; __VA_ARGS__ } DUP(n) { constexpr int rep_ = 1; GSYNC(); __VA_ARGS__ } }
  RUN(0, phase_prologue(p);)
  RUN(1, { Sub s = make_sub(ws + OFF_H0, 1024, 128, ws + OFF_WT_IN, 1024, NP / 256, ws + OFF_P, nullptr, NP); s.f1 = (const float*)(ob + OOFF_RSS); gemm_phase<EPI_PROJ>(s, ws); })
  RUN(2, {
    { Sub s = make_sub((const bf16_t*)(ws + OFF_P) + PQL, NP, 128, ws + OFF_WT_Q, 384, 6, ob + OOFF_Q, nullptr, QW); s.f1 = (const float*)(ob + OOFF_RSS); gemm_phase<EPI_Q>(s, ws); }
    { Sub s = make_sub((const bf16_t*)(ws + OFF_P) + PCKV, NP, 128, ws + OFF_WT_KV, 256, 8, ws + OFF_KN, ws + OFF_VT, 0); s.f1 = (const float*)(ob + OOFF_RSS); gemm_phase<EPI_KV>(s, ws); }
    if (rep_ == 0) {
#if PROBE_PRE2
      for (int it = blockIdx.x; it < 1024; it += gridDim.x) gla_pre_item<true>(p, it);
#endif
      if (gridDim.x == 256) {
        const int c = blockIdx.x, hv = (c & 7) < 4, idx = ((c & 7) & 3) * 32 + (c >> 3), n = hv ? 3 : 5, base = hv ? 640 + 3 * idx : 5 * idx;
        for (int k = 0; k < n; ++k) gla_pre_item<false>(p, base + k);
      } else
        for (int it = blockIdx.x; it < 1024; it += gridDim.x) gla_pre_item<false>(p, it);
    }
  })
  RUN(3, phase_mixers(p);)
  RUN(5, {
    for (size_t i = (size_t)blockIdx.x * 512 + threadIdx.x; i < (OFF_XEND - OFF_SUM1) / 4; i += (size_t)gridDim.x * 512) ((unsigned*)(ws + OFF_SUM1))[i] = 0u;
    { Sub s = make_sub((const bf16_t*)(ws + OFF_P) + PVG, NP, 128, ws + OFF_WT_OG, 1024, 4, ws + OFF_KN, nullptr, 1024); s.f0 = (const float*)(ob + OOFF_SSQ); gemm_phase<EPI_YG>(s, ws); }
    { Sub s = make_sub(ob + OOFF_Q, QW, 192, ws + OFF_WT_OM, 1024, 4, ws + OFF_VT, nullptr, 1024); gemm_phase<EPI_BF16>(s, ws); }
  })
  RUN(6, { Sub s = make_sub(ws + OFF_H0, 1024, 128, ws + OFF_WT_G, 1024, 8, ws + OFF_P, nullptr, 1024);
    s.f0 = p.b_gate; s.b0 = (const bf16_t*)(ws + OFF_KN); s.b1 = (const bf16_t*)(ws + OFF_VT); gemm_phase<EPI_MERGE>(s, ws); })
  const bool fuse = (gridDim.x == 256);
  if (fuse) {
    PHASE(7) { Sub s = make_sub(ws + OFF_P, 1024, 128, ws + OFF_WT_OUT, 1024, 4, nullptr, ws + OFF_KN, 1024);
      s.f0 = p.x; s.f1 = (const float*)(ws + OFF_ST0); s.f2 = p.ln_in_g; s.f3 = p.ln_in_b; s.g2 = p.ln1_g; s.be2 = p.ln1_b;
      s.sums = (float*)(ws + OFF_SUM1); s.cnt = (unsigned*)(ws + OFF_CNT1); s.st_out = (float*)(ws + OFF_ST1); gemm_phase<EPI_RESLN1>(s, ws); }
  } else {
  RUN(7, { Sub s = make_sub(ws + OFF_P, 1024, 128, ws + OFF_WT_OUT, 1024, 4, ws + OFF_KN, nullptr, 1024);
    s.f0 = p.x; s.f1 = (const float*)(ws + OFF_ST0); s.f2 = p.ln_in_g; s.f3 = p.ln_in_b; gemm_phase<EPI_RES>(s, ws); })
  RUN(8, {
    const int wid = threadIdx.x >> 6, lane = threadIdx.x & 63;
    for (int row = blockIdx.x * 8 + wid; row < M_TOK; row += gridDim.x * 8)
      ln_row<0>((const float*)(ws + OFF_KN) + (size_t)row * 1024, p.ln1_g, p.ln1_b, (bf16_t*)ob + (size_t)row * 1024, nullptr, (float*)(ws + OFF_ST1) + 2 * row, lane);
  })
  }
  RUN(9, { Sub s = make_sub(fuse ? (const void*)(ws + OFF_KN) : (const void*)ob, 1024, 128, ob + OOFF_WT_FF1, 1024, 16, ws + OFF_P, nullptr, 4096); gemm_phase<EPI_FF1>(s, ws); })
  if (fuse) {
    PHASE(10) { Sub s = make_sub(ws + OFF_P, 4096, 128, ws + OFF_WT_FF2, 4096, 4, p.out, nullptr, 1024);
      s.b0 = (const bf16_t*)(ws + OFF_KN); s.g2 = p.ln2_g; s.be2 = p.ln2_b;
      s.sums = (float*)(ws + OFF_SUM2); s.cnt = (unsigned*)(ws + OFF_CNT2); gemm_phase<EPI_RESLN2>(s, ws); }
  } else {
  RUN(10, { Sub s = make_sub(ws + OFF_P, 4096, 128, ws + OFF_WT_FF2, 4096, 4, p.out, nullptr, 1024);
    s.f0 = (const float*)(ws + OFF_KN); s.f1 = (const float*)(ws + OFF_ST1); s.f2 = p.ln1_g; s.f3 = p.ln1_b; gemm_phase<EPI_RES>(s, ws); })
  PHASE(11) {
    const int wid = threadIdx.x >> 6, lane = threadIdx.x & 63;
    for (int row = blockIdx.x * 8 + wid; row < M_TOK; row += gridDim.x * 8)
      ln_row<1>(p.out + (size_t)row * 1024, p.ln2_g, p.ln2_b, nullptr, p.out + (size_t)row * 1024, nullptr, lane);
  }
  }
}

extern "C" void kernel_launch(void* const* d_in, const int* in_sizes, int n_in, void* d_out, int out_size, void* d_ws, size_t ws_size, hipStream_t stream) {
  static int grid_blocks = 0;
  if (!grid_blocks) {
    int dev = 0, cus = 0, per_cu = 0;
    hipGetDevice(&dev);
    hipDeviceGetAttribute(&cus, hipDeviceAttributeMultiprocessorCount, dev);
    hipFuncSetAttribute((const void*)mega, hipFuncAttributeMaxDynamicSharedMemorySize, LDS_BYTES);
    hipOccupancyMaxActiveBlocksPerMultiprocessor(&per_cu, (const void*)mega, 512, LDS_BYTES);
    if (per_cu < 1) { fprintf(stderr, "kernel_launch: occupancy query says %d blocks/CU\n", per_cu); per_cu = 1; }
    grid_blocks = cus * 1;
    if (grid_blocks > cus * per_cu) grid_blocks = cus * per_cu;
    if (ws_size < OFF_AS + (size_t)1024 * 4096 * 2) fprintf(stderr, "kernel_launch: workspace too small (%zu)\n", ws_size);
  }
  hipMemsetAsync((unsigned char*)d_ws + OFF_BAR, 0, XCD_BAR_WORDS * 4, stream);
  Params p{};
  p.x = (const float*)d_in[0]; p.pos = (const int*)d_in[1]; p.ln_in_g = (const float*)d_in[2]; p.ln_in_b = (const float*)d_in[3]; p.w_in = (const float*)d_in[4];
  p.w_gla_a2 = (const float*)d_in[5]; p.b_gla_a2 = (const float*)d_in[6]; p.gla_norm_g = (const float*)d_in[7]; p.w_o_gla = (const float*)d_in[8];
  p.q_a_norm_g = (const float*)d_in[9]; p.w_q_b = (const float*)d_in[10]; p.kv_a_norm_g = (const float*)d_in[11]; p.w_kv_b = (const float*)d_in[12];
  p.w_o_mla = (const float*)d_in[13]; p.b_gate = (const float*)d_in[14]; p.w_out = (const float*)d_in[15]; p.ln1_g = (const float*)d_in[16]; p.ln1_b = (const float*)d_in[17];
  p.w_ff1 = (const float*)d_in[18]; p.w_ff2 = (const float*)d_in[19]; p.ln2_g = (const float*)d_in[20]; p.ln2_b = (const float*)d_in[21];
  p.out = (float*)d_out; p.ws = (unsigned char*)d_ws;
#if MULTI_LAUNCH
  for (int ph = 0; ph < 12; ++ph) {
    p.ph_lo = ph; p.ph_hi = ph + 1;
    hipLaunchKernelGGL(mega, dim3(grid_blocks), dim3(512), LDS_BYTES, stream, p);
  }
#else
  p.ph_lo = 0; p.ph_hi = 12;
  void* args[] = {&p};
  hipError_t e = hipLaunchCooperativeKernel((const void*)mega, dim3(grid_blocks), dim3(512), args, LDS_BYTES, stream);
  if (e != hipSuccess) fprintf(stderr, "cooperative launch failed: %s (grid %d)\n", hipGetErrorString(e), grid_blocks);
#endif
}
```

```cpp
#include <hip/hip_runtime.h>
#include <hip/hip_cooperative_groups.h>
#include <cstdio>
#include <cstdint>
namespace cg = cooperative_groups;

#ifndef MULTI_LAUNCH
#define MULTI_LAUNCH 0
#endif
#ifndef PROBE_ATTN2
#define PROBE_ATTN2 0
#endif
#ifndef PROBE_GLA2
#define PROBE_GLA2 0
#endif
#ifndef PROBE_PRE2
#define PROBE_PRE2 0
#endif
#ifndef PROBE_DUP
#define PROBE_DUP 0
#endif

#define DI __device__ __forceinline__
typedef unsigned short bf16_t;
typedef short bf16x8 __attribute__((ext_vector_type(8)));
typedef short s16x4 __attribute__((ext_vector_type(4)));
typedef float f32x4 __attribute__((ext_vector_type(4)));
typedef float f32x2 __attribute__((ext_vector_type(2)));
typedef float f32x16 __attribute__((ext_vector_type(16)));
typedef unsigned u32x4 __attribute__((ext_vector_type(4)));
typedef unsigned u32x2 __attribute__((ext_vector_type(2)));
typedef __bf16 bfv2 __attribute__((ext_vector_type(2)));

constexpr int M_TOK = 16384, DM = 1024, SEQ = 2048, NB = 8;
constexpr int NP = 3840;
constexpr int PQG = 0, PKG = 512, PVG = 1024, PRG = 2048, PQL = 3072, PCKV = 3456, PKR = 3712, PALR = 3776;
constexpr int DIN = 5840;
constexpr int QW = 1536;
constexpr float ALPHA = 1.189207115002721f;
constexpr float QSCALE = 0.07216878364870322f * 1.4426950408889634f;
constexpr float GLA_QS = 0.08838834764831845f;

constexpr size_t OFF_WT_IN = 0;
constexpr size_t OFF_WT_G = OFF_WT_IN + (size_t)NP * 1024 * 2;
constexpr size_t OFF_WT_Q = OFF_WT_G + (size_t)2048 * 1024 * 2;
constexpr size_t OFF_WT_KV = OFF_WT_Q + (size_t)1536 * 384 * 2;
constexpr size_t OFF_WT_OG = OFF_WT_KV + (size_t)2048 * 256 * 2;
constexpr size_t OFF_WT_OM = OFF_WT_OG + (size_t)1024 * 1024 * 2;
constexpr size_t OFF_WT_OUT = OFF_WT_OM + (size_t)1024 * 1024 * 2;
constexpr size_t OFF_COS = OFF_WT_OUT + (size_t)1024 * 1024 * 2;
constexpr size_t OFF_SIN = OFF_COS + (size_t)M_TOK * 32 * 4;
constexpr size_t OFF_SUM1 = OFF_COS, OFF_SUM2 = OFF_SUM1 + (size_t)M_TOK * 8, OFF_CNT1 = OFF_SUM2 + (size_t)M_TOK * 8, OFF_CNT2 = OFF_CNT1 + 64 * 256, OFF_XEND = OFF_CNT2 + 64 * 256;
static_assert(OFF_XEND <= OFF_COS + (size_t)M_TOK * 32 * 4, "exchange overlay");
constexpr size_t OFF_ST0 = OFF_SIN + (size_t)M_TOK * 32 * 4;
constexpr size_t OFF_ST1 = OFF_ST0 + (size_t)M_TOK * 2 * 4;
constexpr size_t OFF_P = OFF_ST1 + (size_t)M_TOK * 2 * 4;
constexpr size_t OFF_H0 = OFF_P + (size_t)M_TOK * NP * 2;
constexpr size_t OFF_KN = OFF_H0 + (size_t)M_TOK * 1024 * 2;
constexpr size_t OFF_VT = OFF_KN + (size_t)M_TOK * 1024 * 2;
constexpr size_t OFF_WT_FF2 = OFF_VT + (size_t)M_TOK * 1024 * 2;
constexpr size_t WS_END = OFF_WT_FF2 + (size_t)1024 * 4096 * 2;
constexpr size_t OFF_AS = WS_END;
constexpr size_t OFF_BAR = OFF_AS + (size_t)1024 * 4096 * 2;
constexpr int XCD_BAR_WORDS = 3456;
static_assert(OFF_BAR + XCD_BAR_WORDS * 4 <= (size_t)256 * 1024 * 1024, "workspace");
constexpr size_t OOFF_Q = 0;
constexpr size_t OOFF_WT_FF1 = (size_t)M_TOK * QW * 2;
constexpr size_t OOFF_SSQ = OOFF_WT_FF1 + (size_t)4096 * 1024 * 2;
constexpr size_t OOFF_EBL = OOFF_SSQ + (size_t)M_TOK * 4 * 16 * 4;
constexpr size_t OOFF_DUMMY = OOFF_EBL + (size_t)1024 * 128 * 4;
constexpr size_t OOFF_RSS = OOFF_DUMMY + (size_t)1024 * 1024;
static_assert(OOFF_RSS + (size_t)M_TOK * 2 * 4 <= (size_t)M_TOK * 1024 * 4, "out scratch");

constexpr int LDS_BYTES = 131072 + 4096;

struct Params {
  const float* x; const int* pos; const float* ln_in_g; const float* ln_in_b; const float* w_in; const float* w_gla_a2; const float* b_gla_a2;
  const float* gla_norm_g; const float* w_o_gla; const float* q_a_norm_g; const float* w_q_b; const float* kv_a_norm_g; const float* w_kv_b;
  const float* w_o_mla; const float* b_gate; const float* w_out; const float* ln1_g; const float* ln1_b; const float* w_ff1; const float* w_ff2;
  const float* ln2_g; const float* ln2_b;
  float* out; unsigned char* ws;
  int ph_lo, ph_hi;
};

extern __shared__ __attribute__((aligned(16))) unsigned char smem[];

DI unsigned pk2(float a, float b) { f32x2 v = {a, b}; bfv2 r = __builtin_convertvector(v, bfv2); return __builtin_bit_cast(unsigned, r); }
DI bf16_t f2bf(float a) { return (bf16_t)(pk2(a, 0.f) & 0xffffu); }
DI float bf2f(unsigned u) { return __uint_as_float(u << 16); }
DI float bflo(unsigned u) { return __uint_as_float(u << 16); }
DI float bfhi(unsigned u) { return __uint_as_float(u & 0xffff0000u); }
DI u32x2 pk4(f32x4 v) { u32x2 r; r.x = pk2(v[0], v[1]); r.y = pk2(v[2], v[3]); return r; }
DI f32x4 unpk4(u32x2 u) { f32x4 r = {bflo(u.x), bfhi(u.x), bflo(u.y), bfhi(u.y)}; return r; }
DI float sigmoidf_(float x) { return __builtin_amdgcn_rcpf(1.0f + __expf(-x)); }
DI float xor32_max(float v) { const auto r = __builtin_amdgcn_permlane32_swap(__float_as_uint(v), __float_as_uint(v), false, false); return fmaxf(__uint_as_float(r[0]), __uint_as_float(r[1])); }
DI float xor32_sum(float v) { const auto r = __builtin_amdgcn_permlane32_swap(__float_as_uint(v), __float_as_uint(v), false, false); return __uint_as_float(r[0]) + __uint_as_float(r[1]); }
DI float xor16_sum(float v) { const auto r = __builtin_amdgcn_permlane16_swap(__float_as_uint(v), __float_as_uint(v), false, false); return __uint_as_float(r[0]) + __uint_as_float(r[1]); }
DI float row16_sum(float v) {
  v += __builtin_bit_cast(float, __builtin_amdgcn_update_dpp(0, __builtin_bit_cast(int, v), 0xB1, 0xF, 0xF, true));
  v += __builtin_bit_cast(float, __builtin_amdgcn_update_dpp(0, __builtin_bit_cast(int, v), 0x4E, 0xF, 0xF, true));
  v += __builtin_bit_cast(float, __builtin_amdgcn_update_dpp(0, __builtin_bit_cast(int, v), 0x141, 0xF, 0xF, true));
  v += __builtin_bit_cast(float, __builtin_amdgcn_update_dpp(0, __builtin_bit_cast(int, v), 0x140, 0xF, 0xF, true));
  return v;
}
DI float wave_sum(float v) { return xor32_sum(xor16_sum(row16_sum(v))); }
DI unsigned xb_ld(unsigned* p) { return __hip_atomic_load(p, __ATOMIC_RELAXED, __HIP_MEMORY_SCOPE_AGENT); }
DI unsigned xb_add(unsigned* p, unsigned v) { return __hip_atomic_fetch_add(p, v, __ATOMIC_RELAXED, __HIP_MEMORY_SCOPE_AGENT); }

#define LBAR() do { asm volatile("s_waitcnt lgkmcnt(0)" ::: "memory"); __builtin_amdgcn_s_barrier(); asm volatile("" ::: "memory"); } while (0)

constexpr int HTB = 128 * 64 * 2;
DI int lds_byte(int r, int c) { int st = (r >> 4) * 2 + (c >> 5), rr = r & 15, cc = c & 31, ob = rr * 64 + cc * 2; return st * 1024 + (ob ^ (((ob >> 9) & 1) << 5)); }
DI void stage_rc(int b, int& R, int& C) { int st = b / 1024, sb = b % 1024, swz = sb ^ (((sb >> 9) & 1) << 5); R = (st >> 1) * 16 + swz / 64; C = (st & 1) * 32 + (swz % 64) / 2; }

enum { EPI_PROJ = 0, EPI_Q = 1, EPI_KV = 2, EPI_BF16 = 3, EPI_MERGE = 4, EPI_RES = 5, EPI_FF1 = 6, EPI_YG = 7, EPI_RESLN1 = 8, EPI_RESLN2 = 9 };
struct Sub {
  const bf16_t* A; int lda; int akblk; const bf16_t* Bt; int K; int nN; int epi; int rsK;
  void* o0; void* o1; int ldo;
  const float* f0; const float* f1; const float* f2; const float* f3; const bf16_t* b0; const bf16_t* b1;
  float* sums; unsigned* cnt; const float* g2; const float* be2; float* st_out;
};

#define LAS __attribute__((address_space(3)))
#define G_SA(b, h) (((b) * 2 + (h)) * HTB)
#define G_SB(b, h) ((4 + (b) * 2 + (h)) * HTB)

DI void store_bf4(bf16_t* p, f32x4 v) { *(u32x2*)p = pk4(v); }
DI void store_bf8(bf16_t* p, f32x4 a, f32x4 b) { const u32x4 w = {pk2(a[0], a[1]), pk2(a[2], a[3]), pk2(b[0], b[1]), pk2(b[2], b[3])}; *(u32x4*)p = w; }
DI int perm32(int rho) { const int n = rho >> 4, i = rho & 15; return 8 * (i >> 2) + 4 * n + (i & 3); }

template <int EPI>
DI void gemm_epilogue(const Sub& s, f32x4 (&acc)[2][2][4][2], int brow, int bcol, const unsigned char* ws) {
  int tid = threadIdx.x; asm volatile("" : "+v"(tid));
  const int wid = tid >> 6, lane = tid & 63, wr = wid >> 2, wc = wid & 3, fr = lane & 15, fq = lane >> 4;
  const float* rstd = (const float*)(smem + 131072);
  constexpr int epi = EPI;
  if (epi == EPI_PROJ || epi == EPI_Q) {
    const float* COS = (const float*)(ws + OFF_COS); const float* SIN = (const float*)(ws + OFF_SIN);
    bf16_t* O = (bf16_t*)s.o0; const int ldo = s.ldo;
#pragma unroll
    for (int ai = 0; ai < 2; ++ai)
#pragma unroll
      for (int m = 0; m < 4; ++m) {
        const int rl = ai * 128 + wr * 64 + m * 16 + fr, row = brow + rl;
        const float sc = (epi == EPI_Q) ? rsqrtf(s.f1[2 * row] * (1.0f / 384.0f) + 1e-6f) * QSCALE : 1.0f;
#pragma unroll
        for (int bj = 0; bj < 2; ++bj) {
          const int c32 = bcol + bj * 128 + wc * 32;
          int ra;
          if (epi == EPI_PROJ) ra = (c32 == PKR) ? 0 : ((c32 == PKR + 32) ? 1 : -1);
          else { const int w32 = c32 % 192; ra = (w32 >= 128) ? ((w32 - 128) >> 5) : -1; }
          f32x4 v0 = acc[ai][bj][m][0] * sc, v1 = acc[ai][bj][m][1] * sc;
          if (ra >= 0) {
            const unsigned ci = (unsigned)row * 32u + ra * 16 + fq * 4; const f32x4 c4 = *(const f32x4*)(COS + ci), s4 = *(const f32x4*)(SIN + ci);
            const f32x4 o0 = v0 * c4 - v1 * s4, o1 = v1 * c4 + v0 * s4; v0 = o0; v1 = o1;
          }
          store_bf8(O + ((unsigned)row * (unsigned)ldo + c32 + fq * 8), v0, v1);
          if (epi == EPI_PROJ && c32 >= PQL && c32 < PKR) {
            float sq = (v0[0] * v0[0] + v0[1] * v0[1]) + (v0[2] * v0[2] + v0[3] * v0[3]) + (v1[0] * v1[0] + v1[1] * v1[1]) + (v1[2] * v1[2] + v1[3] * v1[3]);
            sq = xor32_sum(xor16_sum(sq));
            if (fq == 0) unsafeAtomicAdd(const_cast<float*>(s.f1) + 2 * row + (c32 >= PCKV ? 1 : 0), sq);
          }
        }
      }
  } else if (epi == EPI_KV) {
    bf16_t* KN = (bf16_t*)s.o0; bf16_t* VT = (bf16_t*)s.o1;
#pragma unroll
    for (int ai = 0; ai < 2; ++ai)
#pragma unroll
      for (int m = 0; m < 4; ++m) {
        const int rl = ai * 128 + wr * 64 + m * 16 + fr, row = brow + rl;
        const float sc = rsqrtf(s.f1[2 * row + 1] * (1.0f / 256.0f) + 1e-6f);
        const int b = row >> 11, sq = row & 2047;
#pragma unroll
        for (int bj = 0; bj < 2; ++bj) {
          const int c32 = bcol + bj * 128 + wc * 32, head = c32 >> 8, w32 = c32 & 255;
          { const f32x4 v0 = acc[ai][bj][m][0] * sc, v1 = acc[ai][bj][m][1] * sc;
            if (w32 < 128) store_bf8(KN + ((unsigned)row * 1024u + head * 128 + w32 + fq * 8), v0, v1);
            else store_bf8(VT + ((unsigned)row * 1024u + head * 128 + (w32 - 128) + fq * 8), v0, v1);
          }
        }
        asm volatile("" ::: "memory");
      }
  } else if (epi == EPI_BF16 || epi == EPI_FF1 || epi == EPI_YG) {
    bf16_t* O = (bf16_t*)s.o0; const int ldo = s.ldo;
#pragma unroll
    for (int ai = 0; ai < 2; ++ai)
#pragma unroll
      for (int m = 0; m < 4; ++m) {
        const int rl = ai * 128 + wr * 64 + m * 16 + fr, row = brow + rl;
        const float fin = (epi == EPI_YG) ? rstd[768 + rl] : 1.0f;
#pragma unroll
        for (int bj = 0; bj < 2; ++bj) {
          f32x4 v0 = acc[ai][bj][m][0] * fin, v1 = acc[ai][bj][m][1] * fin;
          if (epi == EPI_FF1) {
#pragma unroll
            for (int e = 0; e < 4; ++e) { const float r0 = fmaxf(v0[e], 0.f), r1 = fmaxf(v1[e], 0.f); v0[e] = r0 * r0; v1[e] = r1 * r1; }
          }
          store_bf8(O + ((unsigned)row * (unsigned)ldo + bcol + bj * 128 + wc * 32 + fq * 8), v0, v1);
        }
      }
  } else if (epi == EPI_MERGE) {
    bf16_t* O = (bf16_t*)s.o0; const float* bg = s.f0; const bf16_t* YG = s.b0; const bf16_t* YM = s.b1;
#pragma unroll
    for (int ai = 0; ai < 2; ++ai)
#pragma unroll
      for (int m = 0; m < 4; ++m) {
        const int row = brow + ai * 128 + wr * 64 + m * 16 + fr;
        { const int ch = (bcol >> 1) + wc * 32 + fq * 8;
          const unsigned oi = (unsigned)row * 1024u + ch;
          const u32x4 ygw = *(const u32x4*)(YG + oi), ymw = *(const u32x4*)(YM + oi);
          f32x4 o[2];
#pragma unroll
          for (int n = 0; n < 2; ++n) {
            const f32x4 a0 = acc[ai][0][m][n] + *(const f32x4*)(bg + ch + 4 * n), a1 = acc[ai][1][m][n] + *(const f32x4*)(bg + 1024 + ch + 4 * n);
            const f32x4 yg = unpk4((u32x2){ygw[2 * n], ygw[2 * n + 1]}), ym = unpk4((u32x2){ymw[2 * n], ymw[2 * n + 1]});
#pragma unroll
            for (int e = 0; e < 4; ++e) o[n][e] = sigmoidf_(a0[e]) * yg[e] + sigmoidf_(a1[e]) * ym[e];
          }
          store_bf8(O + oi, o[0], o[1]);
        }
      }
  } else if (epi == EPI_RESLN1 || epi == EPI_RESLN2) {
    const float* SRC = s.f0; const float* ST = s.f1; const float* GA = s.f2; const float* BE = s.f3;
    float* sums = s.sums; unsigned* cnt = s.cnt + 64 * (brow >> 8);
#pragma unroll
    for (int ai = 0; ai < 2; ++ai)
#pragma unroll
      for (int m = 0; m < 4; ++m) {
        const int row = brow + ai * 128 + wr * 64 + m * 16 + fr;
        int fqo = fq; asm volatile("" : "+v"(fqo));
        float mu = 0.f, rs = 0.f; if (epi == EPI_RESLN1) { mu = ST[2 * row]; rs = ST[2 * row + 1]; }
        float s1 = 0.f, s2 = 0.f;
#pragma unroll
        for (int bj = 0; bj < 2; ++bj)
#pragma unroll
          for (int n = 0; n < 2; ++n) {
            const int col = bcol + bj * 128 + wc * 32 + n * 16 + fqo * 4;
            const unsigned oi = (unsigned)row * 1024u + col;
            f32x4 hres;
            if (epi == EPI_RESLN1) { const f32x4 xs = *(const f32x4*)(SRC + oi), g4 = *(const f32x4*)(GA + col), b4 = *(const f32x4*)(BE + col); hres = (xs - mu) * rs * g4 + b4; }
            else hres = unpk4(*(const u32x2*)(s.b0 + oi));
            const f32x4 v = hres * ALPHA + acc[ai][bj][m][n];
            acc[ai][bj][m][n] = v;
            s1 += (v[0] + v[1]) + (v[2] + v[3]); s2 += (v[0] * v[0] + v[1] * v[1]) + (v[2] * v[2] + v[3] * v[3]);
            asm volatile("" ::: "memory");
          }
        s1 = xor32_sum(xor16_sum(s1)); s2 = xor32_sum(xor16_sum(s2));
        if (fq == 0) { unsafeAtomicAdd(sums + 2 * row, s1); unsafeAtomicAdd(sums + 2 * row + 1, s2); }
        asm volatile("" ::: "memory");
      }
    asm volatile("s_waitcnt vmcnt(0)" ::: "memory");
    if (lane == 0) (void)xb_add(cnt, 1u);
    { unsigned sp = 0u;
      while ((unsigned)__builtin_amdgcn_readfirstlane(xb_ld(cnt)) < 32u) { __builtin_amdgcn_s_sleep(1); if (++sp > (1u << 22)) break; } }
    asm volatile("" ::: "memory");
#pragma unroll
    for (int ai = 0; ai < 2; ++ai)
#pragma unroll
      for (int m = 0; m < 4; ++m) {
        const int row = brow + ai * 128 + wr * 64 + m * 16 + fr;
        int fqo = fq; asm volatile("" : "+v"(fqo));
        const float t1 = __hip_atomic_load(sums + 2 * row, __ATOMIC_RELAXED, __HIP_MEMORY_SCOPE_AGENT), t2 = __hip_atomic_load(sums + 2 * row + 1, __ATOMIC_RELAXED, __HIP_MEMORY_SCOPE_AGENT);
        const float mean = t1 * (1.0f / 1024.0f), var = fmaxf(t2 * (1.0f / 1024.0f) - mean * mean, 0.f), rstd2 = rsqrtf(var + 1e-5f);
#pragma unroll
        for (int bj = 0; bj < 2; ++bj)
#pragma unroll
          for (int n = 0; n < 2; ++n) {
            const int col = bcol + bj * 128 + wc * 32 + n * 16 + fqo * 4;
            const unsigned oi = (unsigned)row * 1024u + col;
            const f32x4 v = acc[ai][bj][m][n];
            const f32x4 y = (v - mean) * rstd2 * *(const f32x4*)(s.g2 + col) + *(const f32x4*)(s.be2 + col);
            if (epi == EPI_RESLN1) store_bf4((bf16_t*)s.o1 + oi, y);
            else *(f32x4*)((float*)s.o0 + oi) = y;
            asm volatile("" ::: "memory");
          }
        asm volatile("" ::: "memory");
      }
  } else {
    float* O = (float*)s.o0; const float* SRC = s.f0; const float* ST = s.f1; const float* GA = s.f2; const float* BE = s.f3;
#pragma unroll
    for (int ai = 0; ai < 2; ++ai)
#pragma unroll
      for (int m = 0; m < 4; ++m) {
        const int row = brow + ai * 128 + wr * 64 + m * 16 + fr;
        const float mu = ST[2 * row], rs = ST[2 * row + 1];
#pragma unroll
        for (int bj = 0; bj < 2; ++bj)
#pragma unroll
          for (int n = 0; n < 2; ++n) {
            const int col = bcol + bj * 128 + wc * 32 + n * 16 + fq * 4;
            const unsigned oi = (unsigned)row * 1024u + col; const f32x4 xs = *(const f32x4*)(SRC + oi), g4 = *(const f32x4*)(GA + col), b4 = *(const f32x4*)(BE + col);
            const f32x4 h = (xs - mu) * rs * g4 + b4;
            *(f32x4*)(O + oi) = h * ALPHA + acc[ai][bj][m][n];
          }
      }
  }
}

template <int EPI>
DI void gemm_phase(const Sub& s, const unsigned char* ws) {
  constexpr bool RS = (EPI == EPI_YG), TAB = (EPI == EPI_YG), ALIGN = true;
  LAS unsigned char* lds = (LAS unsigned char*)smem;
  int tid = threadIdx.x; asm volatile("" : "+v"(tid));
  const int wid = __builtin_amdgcn_readfirstlane(tid >> 6), lane = tid & 63, wr = wid >> 2, wc = wid & 3, fr = lane & 15, fq = lane >> 4;
  const int c = blockIdx.x, G = gridDim.x, ntot = 64 * s.nN, grp = 8 * s.nN;
  const int K = s.K, nt = K / 64, lda = s.lda, akblk = s.akblk;
  const int tbase = (c & 7) * (G >> 3) + (c >> 3);
#define UNIT(i, br, bc) ([&]() -> bool { const int t_ = (i) * G + tbase; if (t_ >= ntot) return false; const int pmg_ = t_ / grp, wi_ = t_ % grp; bc = (wi_ >> 3) * 256; br = (pmg_ * 8 + (wi_ & 7)) * 256; return true; }())
  int brow = 0, bcol = 0, nbrow = 0, nbcol = 0;
  if (!UNIT(0, brow, bcol)) return;
  unsigned voffA[2], voffB[2];
#pragma unroll
  for (int i = 0; i < 2; ++i) { int r, cc; stage_rc(tid * 16 + i * 8192, r, cc); voffA[i] = (unsigned)(r * lda + cc) * 2u; voffB[i] = (unsigned)(r * K + cc) * 2u; }
  const size_t hA = (size_t)128 * lda * 2, hB = (size_t)128 * K * 2;
  const unsigned ldsw = (unsigned)wid * 1024u;
  const int aoff = lds_byte(wr * 64 + fr, fq * 8), boff = lds_byte(wc * 32 + fr, fq * 8);
#define STAGE(bufoff, gbase, voff) do { const char* gb_ = (const char*)(gbase); asm volatile("" : "+s"(gb_));     \
    _Pragma("unroll") for (int i_ = 0; i_ < 2; ++i_) \
    __builtin_amdgcn_global_load_lds((const unsigned*)(gb_ + (voff)[i_]), (LAS unsigned*)(lds + (bufoff) + ldsw + i_ * 8192), 16, 0, 0); } while (0)
#define KA(kt) ((size_t)((((kt) >> 1) * akblk + ((kt) & 1) * 64) * 2))
#define LDA(dst, b, h) _Pragma("unroll") for (int m = 0; m < 4; ++m) _Pragma("unroll") for (int k = 0; k < 2; ++k) \
    dst[m][k] = *(const LAS bf16x8*)(lds + G_SA(b, h) + aoff + m * 2048 + k * 1024)
#define LDB(dst, b, h) _Pragma("unroll") for (int n = 0; n < 2; ++n) _Pragma("unroll") for (int k = 0; k < 2; ++k) \
    dst[n][k] = *(const LAS bf16x8*)(lds + G_SB(b, h) + boff + n * 2048 + k * 1024)
#define MMA(ai, bj, At_, Bt_) do { __builtin_amdgcn_s_setprio(1); \
    _Pragma("unroll") for (int m = 0; m < 4; ++m) _Pragma("unroll") for (int n = 0; n < 2; ++n) _Pragma("unroll") for (int k = 0; k < 2; ++k) \
      acc[ai][bj][m][n] = __builtin_amdgcn_mfma_f32_16x16x32_bf16(Bt_[n][k], At_[m][k], acc[ai][bj][m][n], 0, 0, 0); \
    __builtin_amdgcn_s_setprio(0); } while (0)
#define WAIT_V(n) asm volatile("s_waitcnt vmcnt(" #n ")" ::: "memory")
#define WAIT_L(n) asm volatile("s_waitcnt lgkmcnt(" #n ")" ::: "memory")
#define BAR __builtin_amdgcn_s_barrier()
#define SCHED __builtin_amdgcn_sched_barrier(0)
#define ZERO_ACC() _Pragma("unroll") for (int a_ = 0; a_ < 2; ++a_) _Pragma("unroll") for (int b_ = 0; b_ < 2; ++b_) _Pragma("unroll") for (int m_ = 0; m_ < 4; ++m_) \
    _Pragma("unroll") for (int n_ = 0; n_ < 2; ++n_) acc[a_][b_][m_][n_] = (f32x4){0.f, 0.f, 0.f, 0.f}
#define YG_TABLE(br) do { if (threadIdx.x < 256) { const f32x4* sp = (const f32x4*)(s.f0 + (size_t)((br) + threadIdx.x) * 64); float sh[4]; \
    _Pragma("unroll") for (int hd = 0; hd < 4; ++hd) { const f32x4 a = sp[hd * 4] + sp[hd * 4 + 1] + sp[hd * 4 + 2] + sp[hd * 4 + 3]; sh[hd] = rsqrtf(((a[0] + a[1]) + (a[2] + a[3])) * (1.0f / 256.0f) + 1e-6f); } \
    float* tab = (float*)(smem + 131072); tab[threadIdx.x] = sh[0] / sh[1]; tab[256 + threadIdx.x] = sh[1] / sh[2]; tab[512 + threadIdx.x] = sh[2] / sh[3]; tab[768 + threadIdx.x] = sh[3]; } } while (0)
  f32x4 acc[2][2][4][2];
  ZERO_ACC();
  bf16x8 At[4][2], B0[2][2], B1[2][2];
  const char* cA = (const char*)s.A + (size_t)brow * lda * 2; const char* cB = (const char*)s.Bt + (size_t)bcol * K * 2;
  if (TAB) { YG_TABLE(brow); __syncthreads(); }
  STAGE(G_SB(0, 0), cB, voffB); STAGE(G_SB(0, 1), cB + hB, voffB); STAGE(G_SA(0, 0), cA, voffA); STAGE(G_SA(0, 1), cA + hA, voffA);
  if (wr == 1) BAR;
  WAIT_V(2); BAR;
  STAGE(G_SB(1, 0), cB + 128, voffB); STAGE(G_SA(1, 0), cA + KA(1), voffA); STAGE(G_SB(1, 1), cB + hB + 128, voffB);
  WAIT_V(6); BAR;
  for (int ui = 0;; ++ui) {
    const bool has_next = UNIT(ui + 1, nbrow, nbcol);
    const char* nA = has_next ? (const char*)s.A + (size_t)nbrow * lda * 2 : cA; const char* nB = has_next ? (const char*)s.Bt + (size_t)nbcol * K * 2 : cB;
#pragma nounroll
    for (int t0 = 0; t0 < nt; t0 += (RS ? 4 : 8192)) {
      if (RS && t0 > 0) {
        int fr2 = lane & 15; asm volatile("" : "+v"(fr2));
        const LAS float* rt = (const LAS float*)(lds + 131072) + ((t0 >> 2) - 1) * 256 + wr * 64 + fr2;
#pragma unroll
        for (int ai = 0; ai < 2; ++ai)
#pragma unroll
          for (int m = 0; m < 4; ++m) { const float f = rt[ai * 128 + m * 16];
#pragma unroll
            for (int bj = 0; bj < 2; ++bj)
#pragma unroll
              for (int n = 0; n < 2; ++n) acc[ai][bj][m][n] *= f; }
      }
      const int t1 = RS ? ((t0 + 4 < nt) ? t0 + 4 : nt) : nt;
#pragma nounroll
      for (int t = t0; t < t1; t += 2) {
        const bool last = (t == nt - 2);
        const char* a1 = cA + KA(t + 1);
        const char* a2 = last ? nA : cA + KA(t + 2); const char* b2 = last ? nB : cB + (size_t)(t + 2) * 128;
        const char* a3 = last ? nA + KA(1) : cA + KA(t + 3); const char* b3 = b2 + 128;
        LDB(B0, 0, 0); LDB(B1, 0, 1); SCHED; LDA(At, 0, 0); STAGE(G_SA(1, 1), a1 + hA, voffA);
        WAIT_V(8); WAIT_L(0); BAR; MMA(0, 0, At, B0); MMA(0, 1, At, B1); BAR; SCHED;
        LDA(At, 0, 1); STAGE(G_SB(0, 0), b2, voffB); STAGE(G_SB(0, 1), b2 + hB, voffB); STAGE(G_SA(0, 0), a2, voffA);
        WAIT_V(8); WAIT_L(0); BAR; MMA(1, 0, At, B0); MMA(1, 1, At, B1); BAR; SCHED;
        LDB(B0, 1, 0); LDB(B1, 1, 1); SCHED; LDA(At, 1, 0); STAGE(G_SA(0, 1), a2 + hA, voffA);
        WAIT_V(8); WAIT_L(0); BAR; MMA(0, 0, At, B0); MMA(0, 1, At, B1); BAR; SCHED;
        LDA(At, 1, 1); STAGE(G_SB(1, 0), b3, voffB); STAGE(G_SB(1, 1), b3 + hB, voffB); STAGE(G_SA(1, 0), a3, voffA);
        WAIT_V(8); WAIT_L(0); BAR; MMA(1, 0, At, B0); MMA(1, 1, At, B1); BAR; SCHED;
      }
    }
    if (ALIGN) { if (wr == 0) BAR; }
    { int eb = brow, ec = bcol; asm volatile("" : "+s"(eb), "+s"(ec));
      gemm_epilogue<EPI>(s, acc, eb, ec, ws); }
    if (!has_next) break;
    ZERO_ACC();
    brow = nbrow; bcol = nbcol; cA = nA; cB = nB;
    if (TAB) { BAR; YG_TABLE(brow); asm volatile("s_waitcnt lgkmcnt(0)" ::: "memory"); BAR; if (wr == 1) BAR; }
    else if (ALIGN) { if (wr == 1) BAR; }
  }
  WAIT_V(0);
  if (!ALIGN) { if (wr == 0) BAR; }
  BAR;
#undef UNIT
}

__device__ const double INV_FREQ[32] = {1.0, 0.7498942093324559, 0.5623413251903491, 0.4216965034285823, 0.31622776601683794, 0.23713737056616555, 0.17782794100389226, 0.1333521432163324,
  0.1, 0.07498942093324558, 0.056234132519034905, 0.042169650342858224, 0.03162277660168379, 0.02371373705661655, 0.01778279410038923, 0.01333521432163324,
  0.01, 0.007498942093324559, 0.005623413251903491, 0.004216965034285823, 0.003162277660168379, 0.002371373705661655, 0.001778279410038923, 0.001333521432163324,
  0.001, 0.0007498942093324557, 0.0005623413251903491, 0.0004216965034285823, 0.00031622776601683794, 0.00023713737056616554, 0.00017782794100389227, 0.0001333521432163324};

DI int rope_perm_src(int p) { const int a = p >> 5, fq = (p >> 3) & 3, hh = (p >> 2) & 1, i = 16 * a + 4 * fq + (p & 3); return hh * 32 + i; }
DI int colmap(int kind, int n) {
  switch (kind) {
    case 0:
      if (n < 3072) return n;
      if (n < PCKV) return 3088 + (n - PQL);
      if (n < PKR) return 3472 + (n - PCKV);
      if (n < PALR) return 3472 + 256 + rope_perm_src(n - PKR);
      if (n < PALR + 16) return 3072 + (n - PALR);
      return -1;
    case 1: { const int u = n >> 8, w = n & 255, bj = w >> 7, ch = 128 * u + (w & 127); return 3792 + bj * 1024 + ch; }
    case 2: { const int head = n / 192, w = n % 192; return (w < 128) ? head * 192 + w : head * 192 + 128 + rope_perm_src(w - 128); }
    default: return n;
  }
}
DI void transpose_tile(const float* __restrict__ W, int Nsrc, int K, bf16_t* __restrict__ WT, int n0, int k0, int kind, const float* __restrict__ rowscale, bool perm) {
  float* tile = (float*)smem;
  const int tid = threadIdx.x;
#pragma unroll
  for (int r = 0; r < 2; ++r) {
    const int e = tid + 512 * r, i = e >> 4, j4 = (e & 15) * 4, nd = n0 + j4, sc = colmap(kind, perm ? (nd & ~31) + perm32(nd & 31) : nd);
    f32x4 v = {0.f, 0.f, 0.f, 0.f};
    if (sc >= 0) { v = *(const f32x4*)(W + (size_t)(k0 + i) * Nsrc + sc); if (rowscale) v *= rowscale[k0 + i]; }
    tile[(j4 + 0) * 65 + i] = v[0]; tile[(j4 + 1) * 65 + i] = v[1]; tile[(j4 + 2) * 65 + i] = v[2]; tile[(j4 + 3) * 65 + i] = v[3];
  }
  LBAR();
  { const int j = tid >> 3, i8 = (tid & 7) * 8; const float* tr = tile + j * 65 + i8;
    u32x4 o; o.x = pk2(tr[0], tr[1]); o.y = pk2(tr[2], tr[3]); o.z = pk2(tr[4], tr[5]); o.w = pk2(tr[6], tr[7]);
    *(u32x4*)(WT + (size_t)(n0 + j) * K + k0 + i8) = o; }
  LBAR();
}

template <int MODE>
DI void ln_row(const float* __restrict__ src, const float* __restrict__ g, const float* __restrict__ be, bf16_t* obf, float* of32, float* st, int lane) {
  f32x4 v[4]; float s = 0.f;
#pragma unroll
  for (int i = 0; i < 4; ++i) { v[i] = *(const f32x4*)(src + 8 * (lane + 64 * (i >> 1)) + 4 * (i & 1)); s += (v[i][0] + v[i][1]) + (v[i][2] + v[i][3]); }
  const float mu = wave_sum(s) * (1.0f / 1024.0f);
  float q = 0.f;
#pragma unroll
  for (int i = 0; i < 4; ++i) { const f32x4 dlt = v[i] - mu; q += (dlt[0] * dlt[0] + dlt[1] * dlt[1]) + (dlt[2] * dlt[2] + dlt[3] * dlt[3]); }
  const float rs = rsqrtf(wave_sum(q) * (1.0f / 1024.0f) + 1e-5f);
#pragma unroll
  for (int i = 0; i < 2; ++i) {
    const int c = 8 * (lane + 64 * i);
    const f32x4 o0 = (v[2 * i] - mu) * rs * *(const f32x4*)(g + c) + *(const f32x4*)(be + c), o1 = (v[2 * i + 1] - mu) * rs * *(const f32x4*)(g + c + 4) + *(const f32x4*)(be + c + 4);
    if (MODE == 0) store_bf8(obf + c, o0, o1); else { *(f32x4*)(of32 + c) = o0; *(f32x4*)(of32 + c + 4) = o1; }
  }
  if (MODE == 0 && lane == 0) { st[0] = mu; st[1] = rs; }
}

DI void phase_prologue(const Params& p) {
  unsigned char* ws = p.ws;
  const int tid = threadIdx.x, wid = tid >> 6, lane = tid & 63, G = gridDim.x;
  for (int row = blockIdx.x * 8 + wid; row < M_TOK; row += G * 8)
    ln_row<0>(p.x + (size_t)row * 1024, p.ln_in_g, p.ln_in_b, (bf16_t*)(ws + OFF_H0) + (size_t)row * 1024, nullptr, (float*)(ws + OFF_ST0) + 2 * row, lane);
  for (int idx = blockIdx.x * 512 + tid; idx < M_TOK * 2; idx += G * 512) ((float*)((unsigned char*)p.out + OOFF_RSS))[idx] = 0.f;
  for (int idx = blockIdx.x * 512 + tid; idx < M_TOK * 32; idx += G * 512) {
    const int row = idx >> 5, i = idx & 31;
    const double ang = (double)p.pos[row] * INV_FREQ[i];
    const double n = __builtin_rint(ang * 0.15915494309189535);
    const float r = (float)(ang - n * 6.283185307179586);
    ((float*)(ws + OFF_COS))[idx] = cosf(r); ((float*)(ws + OFF_SIN))[idx] = sinf(r);
  }
  constexpr int T0 = 960, T1 = T0 + 512, T2 = T1 + 144, T3 = T2 + 128, T4 = T3 + 256, T5 = T4 + 256, T6 = T5 + 256, T7 = T6 + 1024, T8 = T7 + 1024;
  for (int t = blockIdx.x; t < T8; t += G) {
    if (t < T0) { const int nt = t >> 4, kt = t & 15; transpose_tile(p.w_in, DIN, 1024, (bf16_t*)(ws + OFF_WT_IN), nt * 64, kt * 64, 0, nullptr, true); }
    else if (t < T1) { const int u = t - T0, nt = u >> 4, kt = u & 15; transpose_tile(p.w_in, DIN, 1024, (bf16_t*)(ws + OFF_WT_G), nt * 64, kt * 64, 1, nullptr, true); }
    else if (t < T2) { const int u = t - T1, nt = u / 6, kt = u % 6; transpose_tile(p.w_q_b, 1536, 384, (bf16_t*)(ws + OFF_WT_Q), nt * 64, kt * 64, 2, p.q_a_norm_g, true); }
    else if (t < T3) { const int u = t - T2, nt = u >> 2, kt = u & 3; transpose_tile(p.w_kv_b, 2048, 256, (bf16_t*)(ws + OFF_WT_KV), nt * 64, kt * 64, 3, p.kv_a_norm_g, true); }
    else if (t < T4) { const int u = t - T3, nt = u >> 4, kt = u & 15; transpose_tile(p.w_o_gla, 1024, 1024, (bf16_t*)(ws + OFF_WT_OG), nt * 64, kt * 64, 3, p.gla_norm_g, true); }
    else if (t < T5) { const int u = t - T4, nt = u >> 4, kt = u & 15; transpose_tile(p.w_o_mla, 1024, 1024, (bf16_t*)(ws + OFF_WT_OM), nt * 64, kt * 64, 3, nullptr, true); }
    else if (t < T6) { const int u = t - T5, nt = u >> 4, kt = u & 15; transpose_tile(p.w_out, 1024, 1024, (bf16_t*)(ws + OFF_WT_OUT), nt * 64, kt * 64, 3, nullptr, false); }
    else if (t < T7) { const int u = t - T6, nt = u >> 4, kt = u & 15; transpose_tile(p.w_ff1, 4096, 1024, (bf16_t*)((unsigned char*)p.out + OOFF_WT_FF1), nt * 64, kt * 64, 3, nullptr, true); }
    else { const int u = t - T7, nt = u >> 6, kt = u & 63; transpose_tile(p.w_ff2, 1024, 4096, (bf16_t*)(ws + OFF_WT_FF2), nt * 64, kt * 64, 3, nullptr, false); }
  }
}

#define MFMA32(a, b, c) __builtin_amdgcn_mfma_f32_32x32x16_bf16((a), (b), (c), 0, 0, 0)
constexpr int KROW = 400, VROW = 320;
constexpr int KBUF = 64 * KROW, VBUF = 64 * VROW;
DI int crow(int i, int h) { return (i & 3) + 8 * (i >> 2) + 4 * h; }

DI void attn_item(const Params& p, int b, int h, int qb, bool dry) {
  unsigned char* ws = p.ws;
  const bf16_t* Pm = (const bf16_t*)(ws + OFF_P);
  const bf16_t* KN = (const bf16_t*)(ws + OFF_KN);
  const bf16_t* VT = (const bf16_t*)(ws + OFF_VT);
  bf16_t* Q = (bf16_t*)((unsigned char*)p.out + OOFF_Q);
  const int tid = threadIdx.x, wid = tid >> 6, lane = tid & 63, l31 = lane & 31, hh = lane >> 5;
  const int q0 = qb * 256, nkt = 4 * (qb + 1);
  const int qrow = q0 + 32 * wid + l31;
  const int last_kt = (q0 + 32 * wid + 31) >> 6;
  unsigned char* Kb = smem; unsigned char* Vb = smem + 2 * KBUF;
  bf16x8 qf[12];
  { LAS unsigned char* qt = (LAS unsigned char*)smem + wid * (32 * 400);
    const bf16_t* qg = Q + (unsigned)((b * 2048 + q0 + 32 * wid + (lane >> 3)) * QW + h * 192 + (lane & 7) * 8);
    LAS unsigned char* qw = qt + (lane >> 3) * 400 + (lane & 7) * 16;
#pragma unroll
    for (int ri = 0; ri < 4; ++ri) {
#pragma unroll
      for (int cj = 0; cj < 3; ++cj) *(LAS u32x4*)(qw + ri * 3200 + cj * 128) = *(const u32x4*)(qg + ri * 8 * QW + cj * 64);
      asm volatile("" ::: "memory");
    }
    asm volatile("s_waitcnt lgkmcnt(0)" ::: "memory");
    { const LAS unsigned char* qr = qt + l31 * 400 + 16 * hh;
#pragma unroll
      for (int ks = 0; ks < 12; ++ks) qf[ks] = *(const LAS bf16x8*)(qr + 32 * ks); }
    LBAR();
  }
  u32x4 kreg[3], vreg[2];
  unsigned kofs[3], vofs[2];
#pragma unroll
  for (int i = 0; i < 3; ++i) { const int e = tid + 512 * i, key = e / 24, cc = e % 24; const unsigned tok = (unsigned)(b * 2048 + key);
    kofs[i] = (cc < 16) ? (unsigned)OFF_KN + (tok * 1024u + h * 128 + cc * 8) * 2u : (unsigned)OFF_P + (tok * (unsigned)NP + PKR + (cc - 16) * 8) * 2u; }
#pragma unroll
  for (int i = 0; i < 2; ++i) { const int e = tid + 512 * i, key = e >> 4, cc = e & 15; vofs[i] = (unsigned)OFF_VT + ((unsigned)(b * 2048 + key) * 1024u + h * 128 + cc * 8) * 2u; }
  auto gload = [&](int) {
#pragma unroll
    for (int i = 0; i < 3; ++i) { kreg[i] = *(const u32x4*)(ws + kofs[i]); kofs[i] += ((tid + 512 * i) % 24 < 16) ? 64u * 2048u : 64u * (unsigned)(NP * 2); }
#pragma unroll
    for (int i = 0; i < 2; ++i) { vreg[i] = *(const u32x4*)(ws + vofs[i]); vofs[i] += 64u * 2048u; }
  };
  int klds[3], vlds[2];
#pragma unroll
  for (int i = 0; i < 3; ++i) { const int e = tid + 512 * i, key = e / 24, cc = e % 24; klds[i] = key * KROW + cc * 16; }
#pragma unroll
  for (int i = 0; i < 2; ++i) { const int e = tid + 512 * i, key = e >> 4, cc = e & 15; vlds[i] = key * VROW + cc * 16; }
  auto lstore = [&](int buf) {
#pragma unroll
    for (int i = 0; i < 3; ++i) *(u32x4*)(Kb + buf * KBUF + klds[i]) = kreg[i];
#pragma unroll
    for (int i = 0; i < 2; ++i) *(u32x4*)(Vb + buf * VBUF + vlds[i]) = vreg[i];
  };
  f32x16 o[4];
#pragma unroll
  for (int t = 0; t < 4; ++t)
#pragma unroll
    for (int i = 0; i < 16; ++i) o[t][i] = 0.f;
  float mrun = -1e30f, lrun = 0.f;
  gload(0); lstore(0); gload(1); LBAR();
  for (int kt = 0; kt < nkt; ++kt) {
    if (kt + 1 < nkt) lstore((kt + 1) & 1);
    if (kt + 2 < nkt) gload(kt + 2);
    if (kt <= last_kt) {
      const unsigned char* kb = Kb + (kt & 1) * KBUF + l31 * KROW + 16 * hh;
      const unsigned char* vb = Vb + (kt & 1) * VBUF + (4 * hh + ((lane & 15) >> 2)) * VROW + 32 * ((lane >> 4) & 1) + 8 * (lane & 3);
      f32x16 s0, s1;
#pragma unroll
      for (int i = 0; i < 16; ++i) { s0[i] = 0.f; s1[i] = 0.f; }
#pragma unroll
      for (int ks = 0; ks < 12; ++ks) {
        const bf16x8 a0 = *(const bf16x8*)(kb + 32 * ks), a1 = *(const bf16x8*)(kb + 32 * KROW + 32 * ks);
        s0 = MFMA32(a0, qf[ks], s0); s1 = MFMA32(a1, qf[ks], s1);
      }
      if (64 * kt + 63 > q0 + 32 * wid) {
#pragma unroll
        for (int i = 0; i < 16; ++i) { const int key = 64 * kt + crow(i, hh);
          if (key > qrow) s0[i] = -1e30f;
          if (key + 32 > qrow) s1[i] = -1e30f; }
      }
      float mx = s0[0];
#pragma unroll
      for (int i = 1; i < 16; ++i) mx = fmaxf(mx, s0[i]);
#pragma unroll
      for (int i = 0; i < 16; ++i) mx = fmaxf(mx, s1[i]);
      mx = xor32_max(mx);
      if (!__all(mx - mrun <= 8.0f)) {
        const float mnew = fmaxf(mrun, mx), alpha = __builtin_amdgcn_exp2f(mrun - mnew);
        mrun = mnew; lrun *= alpha;
#pragma unroll
        for (int t = 0; t < 4; ++t)
#pragma unroll
          for (int i = 0; i < 16; ++i) o[t][i] *= alpha;
      }
      float ps = 0.f;
#pragma unroll
      for (int i = 0; i < 16; ++i) { s0[i] = __builtin_amdgcn_exp2f(s0[i] - mrun); ps += s0[i]; }
#pragma unroll
      for (int kh = 0; kh < 2; ++kh) {
        if (kh == 1) {
#pragma unroll
          for (int i = 0; i < 16; ++i) { s1[i] = __builtin_amdgcn_exp2f(s1[i] - mrun); ps += s1[i]; }
        }
#pragma unroll
        for (int s2 = 0; s2 < 2; ++s2) {
          u32x4 pw;
#pragma unroll
          for (int j = 0; j < 4; ++j) pw[j] = kh ? pk2(s1[8 * s2 + 2 * j], s1[8 * s2 + 2 * j + 1]) : pk2(s0[8 * s2 + 2 * j], s0[8 * s2 + 2 * j + 1]);
          const bf16x8 pf = __builtin_bit_cast(bf16x8, pw);
#pragma unroll
          for (int t = 0; t < 4; ++t) {
            const unsigned char* va = vb + (32 * kh + 16 * s2) * VROW + 64 * t;
            const s16x4 lo = __builtin_amdgcn_ds_read_tr16_b64_v4i16((LAS s16x4*)va), hi = __builtin_amdgcn_ds_read_tr16_b64_v4i16((LAS s16x4*)(va + 8 * VROW));
            o[t] = MFMA32(__builtin_shufflevector(lo, hi, 0, 1, 2, 3, 4, 5, 6, 7), pf, o[t]);
          }
        }
      }
      lrun += ps;
    }
    LBAR();
  }
  const float inv = 1.0f / xor32_sum(lrun);
  { int t2 = threadIdx.x; asm volatile("" : "+v"(t2)); const int lane = t2 & 63, wid = t2 >> 6, l31 = lane & 31, hh = lane >> 5;
    LAS unsigned char* ot = (LAS unsigned char*)smem + wid * (32 * 272);
    LAS unsigned char* ow = ot + l31 * 272 + 8 * hh;
#pragma unroll
    for (int t = 0; t < 4; ++t)
#pragma unroll
      for (int g4 = 0; g4 < 4; ++g4) {
        const f32x4 v = {o[t][4 * g4] * inv, o[t][4 * g4 + 1] * inv, o[t][4 * g4 + 2] * inv, o[t][4 * g4 + 3] * inv};
        *(LAS u32x2*)(ow + (32 * t + 8 * g4) * 2) = pk4(v);
      }
    asm volatile("s_waitcnt lgkmcnt(0)" ::: "memory");
    const LAS unsigned char* orp = ot + (lane >> 4) * 272 + (lane & 15) * 16;
    const unsigned goff = dry ? (unsigned)threadIdx.x * 512u : (unsigned)((b * 2048 + q0 + 32 * wid + (lane >> 4)) * QW + h * 192 + (lane & 15) * 8);
    bf16_t* gb = dry ? (bf16_t*)((unsigned char*)p.out + OOFF_DUMMY) : Q;
#pragma unroll
    for (int i = 0; i < 8; ++i) *(u32x4*)(gb + goff + (dry ? 8u * i : (unsigned)(4 * i * QW))) = *(const LAS u32x4*)(orp + 4 * i * 272);
  }
  LBAR();
}

#define MFMA16(a, b, c) __builtin_amdgcn_mfma_f32_16x16x32_bf16((a), (b), (c), 0, 0, 0)
constexpr int GP_RQ = 0, GP_RK = GP_RQ + 64 * 272, GP_QB = GP_RK + 64 * 272, GP_KB = GP_QB + 64 * 272, GP_ALR = GP_KB + 64 * 272, GP_TOT = GP_ALR + 64 * 16 * 4, GP_END = GP_TOT + 4 * 128 * 4;
static_assert(GP_END <= LDS_BYTES, "gla pre lds");

template <bool DRY>
DI void gla_pre_item(const Params& p, int item) {
  unsigned char* ws = p.ws;
  bf16_t* Pm = (bf16_t*)(ws + OFF_P);
  bf16_t* ASg = (bf16_t*)(ws + OFF_AS);
  float* EBLg = (float*)((unsigned char*)p.out + OOFF_EBL);
  const int c = item & 31, h = (item >> 5) & 3, b = item >> 7;
  const int tid = threadIdx.x, wid = tid >> 6, lane = tid & 63, fr = lane & 15, fq = lane >> 4;
  const int d = tid & 127, rg = tid >> 7;
  const size_t rb = (size_t)(b * 2048 + 64 * c);
  float* ALR = (float*)(smem + GP_ALR); float* TOT = (float*)(smem + GP_TOT);
#pragma unroll
  for (int i = 0; i < 2; ++i) { const int e = tid + 512 * i, row = e >> 4, cc = e & 15; const bf16_t* src = Pm + (rb + row) * NP + h * 128 + cc * 8;
    *(u32x4*)(smem + GP_RQ + row * 272 + cc * 16) = *(const u32x4*)(src + PQG); *(u32x4*)(smem + GP_RK + row * 272 + cc * 16) = *(const u32x4*)(src + PKG); }
  { const int vj = tid >> 3, ar2 = (tid & 7) * 2; const unsigned av = *(const unsigned*)(Pm + (rb + vj) * NP + PALR + ar2); ALR[vj * 16 + ar2] = bflo(av); ALR[vj * 16 + ar2 + 1] = bfhi(av); }
  float w2c[16];
#pragma unroll
  for (int r = 0; r < 16; ++r) w2c[r] = p.w_gla_a2[r * 512 + h * 128 + d];
  const float b2 = p.b_gla_a2[h * 128 + d];
  LBAR();
  float cum[16]; float run = 0.f;
#pragma unroll
  for (int i = 0; i < 16; ++i) {
    const float* ar = ALR + (16 * rg + i) * 16;
    float z = b2;
#pragma unroll
    for (int r = 0; r < 16; ++r) z += ar[r] * w2c[r];
    const float ls = fminf(z, 0.f) - __logf(1.0f + __expf(-fabsf(z)));
    run += ls * (1.0f / 16.0f); cum[i] = run;
  }
  TOT[rg * 128 + d] = run;
  LBAR();
  float off = 0.f, blast = 0.f;
#pragma unroll
  for (int g = 0; g < 4; ++g) { const float tv = TOT[g * 128 + d]; blast += tv; if (g < rg) off += tv; }
  { const bf16_t* RQ = (const bf16_t*)(smem + GP_RQ); const bf16_t* RK = (const bf16_t*)(smem + GP_RK);
    bf16_t* QB = (bf16_t*)(smem + GP_QB); bf16_t* KB = (bf16_t*)(smem + GP_KB);
    unsigned kd[8];
#pragma unroll
    for (int i = 0; i < 16; i += 2) {
      const int r0 = 16 * rg + i;
      const float b0 = off + cum[i], b1 = off + cum[i + 1];
      const float q0 = bf2f(RQ[r0 * 136 + d]), q1 = bf2f(RQ[(r0 + 1) * 136 + d]), k0 = bf2f(RK[r0 * 136 + d]), k1 = bf2f(RK[(r0 + 1) * 136 + d]);
      const bf16_t qb0 = f2bf(q0 * __expf(b0) * GLA_QS), qb1 = f2bf(q1 * __expf(b1) * GLA_QS);
      QB[r0 * 136 + d] = qb0; QB[(r0 + 1) * 136 + d] = qb1;
      KB[r0 * 136 + d] = f2bf(k0 * __expf(-b0)); KB[(r0 + 1) * 136 + d] = f2bf(k1 * __expf(-b1));
      kd[i >> 1] = pk2(k0 * __expf(blast - b0), k1 * __expf(blast - b1));
    }
    u32x4* kdt = DRY ? (u32x4*)((unsigned char*)p.out + OOFF_DUMMY + tid * 32) : (u32x4*)(Pm + (rb + (d >> 1)) * NP + PKG + h * 128 + (d & 1) * 64 + 16 * rg);
    kdt[0] = (u32x4){kd[0], kd[1], kd[2], kd[3]}; kdt[1] = (u32x4){kd[4], kd[5], kd[6], kd[7]};
    if (rg == 0 && !DRY) EBLg[item * 128 + d] = __expf(blast);
  }
  LBAR();
#pragma unroll
  for (int i = 0; i < 2; ++i) { const int e = tid + 512 * i, row = e >> 4, cc = e & 15;
    bf16_t* dst = DRY ? (bf16_t*)((unsigned char*)p.out + OOFF_DUMMY) + e * 8 : Pm + (rb + row) * NP + PQG + h * 128 + cc * 8;
    *(u32x4*)dst = *(const u32x4*)(smem + GP_QB + row * 272 + cc * 16); }
  { const int ti = wid >> 1, tv = wid & 1;
    const unsigned char* qa = smem + GP_QB + (16 * ti + fr) * 272 + 16 * fq;
    bf16x8 qfr[4];
#pragma unroll
    for (int ks = 0; ks < 4; ++ks) qfr[ks] = *(const bf16x8*)(qa + 64 * ks);
#pragma unroll
    for (int x = 0; x < 2; ++x) {
      const int tj = 2 * tv + x;
      f32x4 sa = {0.f, 0.f, 0.f, 0.f};
      if (tj <= ti) {
        const unsigned char* ka = smem + GP_KB + (16 * tj + fr) * 272 + 16 * fq;
#pragma unroll
        for (int ks = 0; ks < 4; ++ks) sa = MFMA16(qfr[ks], *(const bf16x8*)(ka + 64 * ks), sa);
        if (tj == ti) {
#pragma unroll
          for (int e = 0; e < 4; ++e) if (fr > 4 * fq + e) sa[e] = 0.f;
        }
      }
#pragma unroll
      for (int e = 0; e < 4; ++e) ((bf16_t*)(smem + GP_RQ))[(16 * ti + 4 * fq + e) * 72 + 16 * tj + fr] = f2bf(sa[e]);
    }
  }
  LBAR();
  { bf16_t* dst = DRY ? (bf16_t*)((unsigned char*)p.out + OOFF_DUMMY) + 0x40000 + tid * 8 : ASg + (size_t)item * 4096 + (tid >> 3) * 64 + (tid & 7) * 8;
    *(u32x4*)dst = *(const u32x4*)(smem + GP_RQ + (tid >> 3) * 144 + (tid & 7) * 16); }
  LBAR();
}

constexpr int GS_QB = 0, GS_KDT = GS_QB + 64 * 272, GS_AS = GS_KDT + 128 * 144, GS_VT = GS_AS + 64 * 144, GS_EBL = GS_VT + 32 * 144, GS_BUF = GS_EBL + 512;
constexpr int GS_SB = 2 * GS_BUF, GS_END = GS_SB + 2 * 32 * 272;
static_assert(GS_END <= LDS_BYTES, "gla scan lds");

struct GlaRegs { u32x4 qb[2], kd[2], as, v; float ebl; bf16_t rr[4]; };

DI void gla_scan_item(const Params& p, int b, int h, int s8, bool dry) {
  unsigned char* ws = p.ws;
  bf16_t* Pm = (bf16_t*)(ws + OFF_P);
  const bf16_t* ASg = (const bf16_t*)(ws + OFF_AS);
  const float* EBLg = (const float*)((unsigned char*)p.out + OOFF_EBL);
  float* SSQ = (float*)((unsigned char*)p.out + OOFF_SSQ);
  const int tid = threadIdx.x, wid = tid >> 6, lane = tid & 63, fr = lane & 15, fq = lane >> 4;
  const int ti = wid >> 1, tv = wid & 1;
  const int vcol = PVG + h * 256 + s8 * 32, rcol = PRG + h * 256 + s8 * 32;
  const int item0 = (b * 4 + h) * 32;
  for (int e = tid; e < 2 * 32 * 272 / 4; e += 512) ((unsigned*)(smem + GS_SB))[e] = 0u;
  f32x4 st[2] = {{0.f, 0.f, 0.f, 0.f}, {0.f, 0.f, 0.f, 0.f}};
  unsigned oqb[2], okd[2], oas, ov, oeb, orr[4];
#pragma unroll
  for (int i = 0; i < 2; ++i) { const int e = tid + 512 * i;
    { const int row = e >> 4, cc = e & 15; oqb[i] = (unsigned)OFF_P + ((unsigned)(b * 2048 + row) * (unsigned)NP + PQG + h * 128 + cc * 8) * 2u; }
    { const int dk = e >> 3, j8 = e & 7; okd[i] = (unsigned)OFF_P + ((unsigned)(b * 2048 + (dk >> 1)) * (unsigned)NP + PKG + h * 128 + (dk & 1) * 64 + j8 * 8) * 2u; } }
  oas = (unsigned)OFF_AS + ((unsigned)item0 * 4096u + tid * 8) * 2u;
  ov = (unsigned)OFF_P + ((unsigned)(b * 2048 + (tid >> 2)) * (unsigned)NP + vcol + (tid & 3) * 8) * 2u;
  oeb = (unsigned)(item0 * 128 + (tid & 127)) * 4u;
#pragma unroll
  for (int e = 0; e < 4; ++e) orr[e] = (unsigned)OFF_P + ((unsigned)(b * 2048 + 16 * ti + 4 * fq + e) * (unsigned)NP + rcol + 16 * tv + fr) * 2u;
  auto gload = [&](GlaRegs& R, int) {
    constexpr unsigned CH = 64u * (unsigned)NP * 2u;
#pragma unroll
    for (int i = 0; i < 2; ++i) { R.qb[i] = *(const u32x4*)(ws + oqb[i]); oqb[i] += CH; R.kd[i] = *(const u32x4*)(ws + okd[i]); okd[i] += CH; }
    R.as = *(const u32x4*)(ws + oas); oas += 8192u;
    if (tid < 256) R.v = *(const u32x4*)(ws + ov);
    ov += CH;
    if (tid < 128) R.ebl = *(const float*)((const unsigned char*)EBLg + oeb);
    oeb += 512u;
#pragma unroll
    for (int e = 0; e < 4; ++e) { R.rr[e] = *(const bf16_t*)(ws + orr[e]); orr[e] += CH; }
  };
  auto lstore = [&](const GlaRegs& R, int buf) {
    unsigned char* B = smem + buf * GS_BUF;
#pragma unroll
    for (int i = 0; i < 2; ++i) { const int e = tid + 512 * i;
      { const int row = e >> 4, cc = e & 15; *(u32x4*)(B + GS_QB + row * 272 + cc * 16) = R.qb[i]; }
      { const int dk = e >> 3, j8 = e & 7; *(u32x4*)(B + GS_KDT + dk * 144 + j8 * 16) = R.kd[i]; } }
    *(u32x4*)(B + GS_AS + (tid >> 3) * 144 + (tid & 7) * 16) = R.as;
    if (tid < 256) { bf16_t* vt = (bf16_t*)(B + GS_VT); const int j = tid >> 2, c8 = (tid & 3) * 8;
#pragma unroll
      for (int e = 0; e < 4; ++e) { vt[(c8 + 2 * e) * 72 + j] = (bf16_t)(R.v[e] & 0xffffu); vt[(c8 + 2 * e + 1) * 72 + j] = (bf16_t)(R.v[e] >> 16); } }
    if (tid < 128) ((float*)(B + GS_EBL))[tid] = R.ebl;
  };
  auto compute = [&](int c, const bf16_t (&rr)[4]) {
    const unsigned char* B = smem + (c & 1) * GS_BUF;
    const unsigned char* SBr = smem + GS_SB + (c & 1) * (32 * 272);
    bf16_t* SBw = (bf16_t*)(smem + GS_SB + ((c + 1) & 1) * (32 * 272));
    const size_t rb = (size_t)(b * 2048 + 64 * c);
    f32x4 oacc = {0.f, 0.f, 0.f, 0.f};
    { const unsigned char* qa = B + GS_QB + (16 * ti + fr) * 272 + 16 * fq;
      const unsigned char* sb = SBr + (16 * tv + fr) * 272 + 16 * fq;
#pragma unroll
      for (int ks = 0; ks < 4; ++ks) oacc = MFMA16(*(const bf16x8*)(qa + 64 * ks), *(const bf16x8*)(sb + 64 * ks), oacc); }
    const unsigned char* aa = B + GS_AS + (16 * ti + fr) * 144 + 16 * fq;
    const unsigned char* vb = B + GS_VT + (16 * tv + fr) * 144 + 16 * fq;
    bf16x8 vfr[2];
#pragma unroll
    for (int ks = 0; ks < 2; ++ks) { vfr[ks] = *(const bf16x8*)(vb + 64 * ks); oacc = MFMA16(*(const bf16x8*)(aa + 64 * ks), vfr[ks], oacc); }
#pragma unroll
    for (int e = 0; e < 4; ++e) {
      const float o = oacc[e], r = bf2f(rr[e]);
      float sq = o * o;
      sq = row16_sum(sq);
      const size_t row = rb + 16 * ti + 4 * fq + e;
      bf16_t* od = dry ? (bf16_t*)((unsigned char*)p.out + OOFF_DUMMY) + threadIdx.x * 8 + e : Pm + row * NP + vcol + 16 * tv + fr;
      *od = f2bf(o * r * sigmoidf_(r));
      if (fr == 0 && !dry) SSQ[(row * 4 + h) * 16 + s8 * 2 + tv] = sq;
    }
    const float* EBL = (const float*)(B + GS_EBL);
#pragma unroll
    for (int x = 0; x < 2; ++x) {
      const int tk = 2 * ti + x;
      const float dec = EBL[16 * tk + fr];
      st[x] = st[x] * dec;
      const unsigned char* kb = B + GS_KDT + (16 * tk + fr) * 144 + 16 * fq;
#pragma unroll
      for (int ks = 0; ks < 2; ++ks) st[x] = MFMA16(vfr[ks], *(const bf16x8*)(kb + 64 * ks), st[x]);
#pragma unroll
      for (int e = 0; e < 4; ++e) SBw[(16 * tv + 4 * fq + e) * 136 + 16 * tk + fr] = f2bf(st[x][e]);
    }
  };
  GlaRegs R0, R1;
  gload(R0, 0); gload(R1, 1);
  lstore(R0, 0);
  bf16_t rc[4];
#pragma unroll
  for (int e = 0; e < 4; ++e) rc[e] = R0.rr[e];
  LBAR();
#pragma nounroll
  for (int c = 0; c < 32; c += 2) {
    if (c + 2 < 32) gload(R0, c + 2);
    compute(c, rc);
    lstore(R1, 1);
#pragma unroll
    for (int e = 0; e < 4; ++e) rc[e] = R1.rr[e];
    LBAR();
    if (c + 3 < 32) gload(R1, c + 3);
    compute(c + 1, rc);
    if (c + 2 < 32) { lstore(R0, 0);
#pragma unroll
      for (int e = 0; e < 4; ++e) rc[e] = R0.rr[e]; }
    LBAR();
  }
}

template <bool DRY>
DI void run_attn(const Params& p) {
  const int c = blockIdx.x, G = gridDim.x;
  for (int r = 0; r * G < 512; ++r) {
    const int si = (r & 1) ? ((r + 1) * G - 1 - c) : (r * G + c);
    if (si < 512) { const int qb = 7 - (si >> 6), bh = si & 63; attn_item(p, bh >> 3, bh & 7, qb, DRY); }
  }
}
template <bool DRY>
DI void run_gla(const Params& p) {
  const int c = blockIdx.x, G = gridDim.x;
  for (int it0 = c; it0 < 256; it0 += G) { const int it = (G == 256) ? ((c & 7) * 32 + (c >> 3)) : it0; gla_scan_item(p, it >> 5, (it >> 3) & 3, it & 7, DRY); }
}
DI void phase_mixers(const Params& p) {
#if PROBE_ATTN2
  run_attn<true>(p);
#endif
  run_attn<false>(p);
#if PROBE_GLA2
  run_gla<true>(p);
#endif
  run_gla<false>(p);
}

#define XB_TMO      128
#define XB_XCNT(j)  (256  + 64 * (j))
#define XB_XSUB(j)  (1280 + 64 * (j))
#define XB_XGEN(j)  (2304 + 64 * (j))
#define XB_TOP      3328
#define XB_TOPGEN   3392
#define XB_SPIN_CAP (1u << 22)
__shared__ unsigned g_xb_st[4];
#define XB_SPIN(cond, bar) do { unsigned _sp = 0; while (cond) { __builtin_amdgcn_s_sleep(1); \
    if ((++_sp & 255u) == 0u) { if (xb_ld(&(bar)[XB_TMO])) break; if (_sp > XB_SPIN_CAP) { atomicAdd(&(bar)[XB_TMO], 1u); break; } } } } while (0)
DI void xcd_barrier_post(unsigned* bar) {
  if (threadIdx.x == 0) { const unsigned x = (unsigned)__builtin_amdgcn_s_getreg((3 << 11) | 20) & 0xFu; g_xb_st[0] = 0u; g_xb_st[1] = 0u; g_xb_st[2] = x; (void)xb_add(&bar[XB_XCNT(x)], 1u); }
  __syncthreads();
}
DI void xcd_barrier(unsigned* bar) {
  asm volatile("s_waitcnt vmcnt(0)" ::: "memory");
  __syncthreads();
  if (threadIdx.x == 0) {
    __builtin_amdgcn_s_waitcnt(0);
    volatile unsigned* st = g_xb_st;
    unsigned nloc = st[0], nx = st[1]; const unsigned x = st[2];
    if (nloc == 0u) {
      const unsigned G = gridDim.x; unsigned sum, cnt, mine, sp = 0u;
      for (;;) {
        sum = 0u; cnt = 0u; mine = 0u;
        for (unsigned j = 0; j < 16; ++j) { const unsigned c = xb_ld(&bar[XB_XCNT(j)]); sum += c; cnt += (c > 0u) ? 1u : 0u; mine = (j == x) ? c : mine; }
        if (sum == G) break;
        __builtin_amdgcn_s_sleep(1);
        if ((++sp & 255u) == 0u) { if (xb_ld(&bar[XB_TMO])) break; if (sp > XB_SPIN_CAP) { atomicAdd(&bar[XB_TMO], 1u); break; } }
      }
      nloc = mine > 0u ? mine : 1u; nx = cnt > 0u ? cnt : 1u; st[0] = nloc; st[1] = nx;
    }
    const unsigned old = xb_add(&bar[XB_XSUB(x)], 1u);
    const unsigned gen = old / nloc;
    if (old + 1u == (gen + 1u) * nloc) {
      __builtin_amdgcn_fence(__ATOMIC_RELEASE, "agent");
      asm volatile("s_waitcnt vmcnt(0)" ::: "memory");
      const unsigned og = xb_add(&bar[XB_TOP], 1u);
      const unsigned tg = og / nx;
      if (og + 1u == (tg + 1u) * nx) xb_add(&bar[XB_TOPGEN], 1u);
      else XB_SPIN(xb_ld(&bar[XB_TOPGEN]) == tg, bar);
      __builtin_amdgcn_fence(__ATOMIC_ACQUIRE, "agent");
      xb_add(&bar[XB_XGEN(x)], 1u);
      asm volatile("s_waitcnt vmcnt(0)" ::: "memory");
    } else {
      XB_SPIN(xb_ld(&bar[XB_XGEN(x)]) == gen, bar);
      __builtin_amdgcn_fence(__ATOMIC_ACQUIRE, "agent");
      asm volatile("s_waitcnt vmcnt(0)" ::: "memory");
    }
  }
  __syncthreads();
}

DI Sub make_sub(const void* A, int lda, int akblk, const void* Bt, int K, int nN, void* o0, void* o1, int ldo) {
  Sub z; z.A = (const bf16_t*)A; z.lda = lda; z.akblk = akblk; z.Bt = (const bf16_t*)Bt; z.K = K; z.nN = nN; z.epi = 0; z.rsK = 0; z.o0 = o0; z.o1 = o1; z.ldo = ldo;
  z.f0 = z.f1 = z.f2 = z.f3 = nullptr; z.b0 = z.b1 = nullptr; z.sums = nullptr; z.cnt = nullptr; z.g2 = z.be2 = nullptr; z.st_out = nullptr; return z;
}

__global__ void __launch_bounds__(512) mega(Params p) {
  cg::grid_group grid = cg::this_grid();
  unsigned char* ws = p.ws;
  unsigned char* ob = (unsigned char*)p.out;
  const int lo = p.ph_lo, hi = p.ph_hi;
  unsigned* bar = (unsigned*)(ws + OFF_BAR);
  if (lo < 0) grid.sync();
  xcd_barrier_post(bar);
#define GSYNC() xcd_barrier(bar)
#define PHASE(n) if (lo <= (n) && (n) < hi && (((n) > lo) ? (GSYNC(), true) : true))
#define DUP(n) if ((PROBE_DUP >> (n)) & 1)
#define RUN(n, ...) PHASE(n) { { constexpr int rep_ = 0; __VA_ARGS__ } DUP(n) { constexpr int rep_ = 1; GSYNC(); __VA_ARGS__ } }
  RUN(0, phase_prologue(p);)
  RUN(1, { Sub s = make_sub(ws + OFF_H0, 1024, 128, ws + OFF_WT_IN, 1024, NP / 256, ws + OFF_P, nullptr, NP); s.f1 = (const float*)(ob + OOFF_RSS); gemm_phase<EPI_PROJ>(s, ws); })
  RUN(2, {
    { Sub s = make_sub((const bf16_t*)(ws + OFF_P) + PQL, NP, 128, ws + OFF_WT_Q, 384, 6, ob + OOFF_Q, nullptr, QW); s.f1 = (const float*)(ob + OOFF_RSS); gemm_phase<EPI_Q>(s, ws); }
    { Sub s = make_sub((const bf16_t*)(ws + OFF_P) + PCKV, NP, 128, ws + OFF_WT_KV, 256, 8, ws + OFF_KN, ws + OFF_VT, 0); s.f1 = (const float*)(ob + OOFF_RSS); gemm_phase<EPI_KV>(s, ws); }
    if (rep_ == 0) {
#if PROBE_PRE2
      for (int it = blockIdx.x; it < 1024; it += gridDim.x) gla_pre_item<true>(p, it);
#endif
      if (gridDim.x == 256) {
        const int c = blockIdx.x, hv = (c & 7) < 4, idx = ((c & 7) & 3) * 32 + (c >> 3), n = hv ? 3 : 5, base = hv ? 640 + 3 * idx : 5 * idx;
        for (int k = 0; k < n; ++k) gla_pre_item<false>(p, base + k);
      } else
        for (int it = blockIdx.x; it < 1024; it += gridDim.x) gla_pre_item<false>(p, it);
    }
  })
  RUN(3, phase_mixers(p);)
  RUN(5, {
    for (size_t i = (size_t)blockIdx.x * 512 + threadIdx.x; i < (OFF_XEND - OFF_SUM1) / 4; i += (size_t)gridDim.x * 512) ((unsigned*)(ws + OFF_SUM1))[i] = 0u;
    { Sub s = make_sub((const bf16_t*)(ws + OFF_P) + PVG, NP, 128, ws + OFF_WT_OG, 1024, 4, ws + OFF_KN, nullptr, 1024); s.f0 = (const float*)(ob + OOFF_SSQ); gemm_phase<EPI_YG>(s, ws); }
    { Sub s = make_sub(ob + OOFF_Q, QW, 192, ws + OFF_WT_OM, 1024, 4, ws + OFF_VT, nullptr, 1024); gemm_phase<EPI_BF16>(s, ws); }
  })
  RUN(6, { Sub s = make_sub(ws + OFF_H0, 1024, 128, ws + OFF_WT_G, 1024, 8, ws + OFF_P, nullptr, 1024);
    s.f0 = p.b_gate; s.b0 = (const bf16_t*)(ws + OFF_KN); s.b1 = (const bf16_t*)(ws + OFF_VT); gemm_phase<EPI_MERGE>(s, ws); })
  const bool fuse = (gridDim.x == 256);
  if (fuse) {
    PHASE(7) { Sub s = make_sub(ws + OFF_P, 1024, 128, ws + OFF_WT_OUT, 1024, 4, nullptr, ws + OFF_KN, 1024);
      s.f0 = p.x; s.f1 = (const float*)(ws + OFF_ST0); s.f2 = p.ln_in_g; s.f3 = p.ln_in_b; s.g2 = p.ln1_g; s.be2 = p.ln1_b;
      s.sums = (float*)(ws + OFF_SUM1); s.cnt = (unsigned*)(ws + OFF_CNT1); s.st_out = (float*)(ws + OFF_ST1); gemm_phase<EPI_RESLN1>(s, ws); }
  } else {
  RUN(7, { Sub s = make_sub(ws + OFF_P, 1024, 128, ws + OFF_WT_OUT, 1024, 4, ws + OFF_KN, nullptr, 1024);
    s.f0 = p.x; s.f1 = (const float*)(ws + OFF_ST0); s.f2 = p.ln_in_g; s.f3 = p.ln_in_b; gemm_phase<EPI_RES>(s, ws); })
  RUN(8, {
    const int wid = threadIdx.x >> 6, lane = threadIdx.x & 63;
    for (int row = blockIdx.x * 8 + wid; row < M_TOK; row += gridDim.x * 8)
      ln_row<0>((const float*)(ws + OFF_KN) + (size_t)row * 1024, p.ln1_g, p.ln1_b, (bf16_t*)ob + (size_t)row * 1024, nullptr, (float*)(ws + OFF_ST1) + 2 * row, lane);
  })
  }
  RUN(9, { Sub s = make_sub(fuse ? (const void*)(ws + OFF_KN) : (const void*)ob, 1024, 128, ob + OOFF_WT_FF1, 1024, 16, ws + OFF_P, nullptr, 4096); gemm_phase<EPI_FF1>(s, ws); })
  if (fuse) {
    PHASE(10) { Sub s = make_sub(ws + OFF_P, 4096, 128, ws + OFF_WT_FF2, 4096, 4, p.out, nullptr, 1024);
      s.b0 = (const bf16_t*)(ws + OFF_KN); s.g2 = p.ln2_g; s.be2 = p.ln2_b;
      s.sums = (float*)(ws + OFF_SUM2); s.cnt = (unsigned*)(ws + OFF_CNT2); gemm_phase<EPI_RESLN2>(s, ws); }
  } else {
  RUN(10, { Sub s = make_sub(ws + OFF_P, 4096, 128, ws + OFF_WT_FF2, 4096, 4, p.out, nullptr, 1024);
    s.f0 = (const float*)(ws + OFF_KN); s.f1 = (const float*)(ws + OFF_ST1); s.f2 = p.ln1_g; s.f3 = p.ln1_b; gemm_phase<EPI_RES>(s, ws); })
  PHASE(11) {
    const int wid = threadIdx.x >> 6, lane = threadIdx.x & 63;
    for (int row = blockIdx.x * 8 + wid; row < M_TOK; row += gridDim.x * 8)
      ln_row<1>(p.out + (size_t)row * 1024, p.ln2_g, p.ln2_b, nullptr, p.out + (size_t)row * 1024, nullptr, lane);
  }
  }
}

extern "C" void kernel_launch(void* const* d_in, const int* in_sizes, int n_in, void* d_out, int out_size, void* d_ws, size_t ws_size, hipStream_t stream) {
  static int grid_blocks = 0;
  if (!grid_blocks) {
    int dev = 0, cus = 0, per_cu = 0;
    hipGetDevice(&dev);
    hipDeviceGetAttribute(&cus, hipDeviceAttributeMultiprocessorCount, dev);
    hipFuncSetAttribute((const void*)mega, hipFuncAttributeMaxDynamicSharedMemorySize, LDS_BYTES);
    hipOccupancyMaxActiveBlocksPerMultiprocessor(&per_cu, (const void*)mega, 512, LDS_BYTES);
    if (per_cu < 1) { fprintf(stderr, "kernel_launch: occupancy query says %d blocks/CU\n", per_cu); per_cu = 1; }
    grid_blocks = cus * 1;
    if (grid_blocks > cus * per_cu) grid_blocks = cus * per_cu;
    if (ws_size < OFF_AS + (size_t)1024 * 4096 * 2) fprintf(stderr, "kernel_launch: workspace too small (%zu)\n", ws_size);
  }
  hipMemsetAsync((unsigned char*)d_ws + OFF_BAR, 0, XCD_BAR_WORDS * 4, stream);
  Params p{};
  p.x = (const float*)d_in[0]; p.pos = (const int*)d_in[1]; p.ln_in_g = (const float*)d_in[2]; p.ln_in_b = (const float*)d_in[3]; p.w_in = (const float*)d_in[4];
  p.w_gla_a2 = (const float*)d_in[5]; p.b_gla_a2 = (const float*)d_in[6]; p.gla_norm_g = (const float*)d_in[7]; p.w_o_gla = (const float*)d_in[8];
  p.q_a_norm_g = (const float*)d_in[9]; p.w_q_b = (const float*)d_in[10]; p.kv_a_norm_g = (const float*)d_in[11]; p.w_kv_b = (const float*)d_in[12];
  p.w_o_mla = (const float*)d_in[13]; p.b_gate = (const float*)d_in[14]; p.w_out = (const float*)d_in[15]; p.ln1_g = (const float*)d_in[16]; p.ln1_b = (const float*)d_in[17];
  p.w_ff1 = (const float*)d_in[18]; p.w_ff2 = (const float*)d_in[19]; p.ln2_g = (const float*)d_in[20]; p.ln2_b = (const float*)d_in[21];
  p.out = (float*)d_out; p.ws = (unsigned char*)d_ws;
#if MULTI_LAUNCH
  for (int ph = 0; ph < 12; ++ph) {
    p.ph_lo = ph; p.ph_hi = ph + 1;
    hipLaunchKernelGGL(mega, dim3(grid_blocks), dim3(512), LDS_BYTES, stream, p);
  }
#else
  p.ph_lo = 0; p.ph_hi = 12;
  void* args[] = {&p};
  hipError_t e = hipLaunchCooperativeKernel((const void*)mega, dim3(grid_blocks), dim3(512), args, LDS_BYTES, stream);
  if (e != hipSuccess) fprintf(stderr, "cooperative launch failed: %s (grid %d)\n", hipGetErrorString(e), grid_blocks);
#endif
}
```
